# Optimizing an MI355X kernel written in HIP

```python
import jax, jax.numpy as jnp
from jax import lax
import numpy as np


D_MODEL = 2048
BATCH = 1
SEQ = 16384
DEPTH = 1

N_MEM = 256
EPS = 1e-6
RET_HEADS = 4
RET_DK = 256
RET_DV = 256
RET_CHUNK = 128
RET_THETA = 10000.0
SWA_HEADS = 16
SWA_KV_HEADS = 4
SWA_HD = 64
WINDOW = 128
ROPE_THETA = 500000.0
ROPE_DIM = SWA_HD // 4
X_HEADS = 4
X_HD = 128
D_FF = -(-8 * D_MODEL // (3 * 256)) * 256
IN_SPLITS = (RET_HEADS * RET_DK, RET_HEADS * RET_DK, RET_HEADS * RET_DV, RET_HEADS * RET_DV,
             SWA_HEADS * SWA_HD, SWA_KV_HEADS * SWA_HD, SWA_KV_HEADS * SWA_HD,
             D_MODEL, D_MODEL)
D_IN = sum(IN_SPLITS)
NEG = -1e30

kernel_name = 'hybrid_retention_swa_block'


def rmsnorm(x, g=None):
    xf = x.astype(jnp.float32)
    y = xf * lax.rsqrt(jnp.mean(xf * xf, axis=-1, keepdims=True) + EPS)
    if g is not None:
        y = y * g.astype(jnp.float32)
    return y.astype(x.dtype)


def to_heads(t, n_heads):
    b, s, _ = t.shape
    return t.reshape(b, s, n_heads, -1).transpose(0, 2, 1, 3)


def rope(x, pos, theta, rot_dim):
    half = rot_dim // 2
    inv = 1.0 / (theta ** (jnp.arange(half, dtype=jnp.float32) / half))
    ang = pos.astype(jnp.float32)[:, None, :, None] * inv
    cos, sin = jnp.cos(ang), jnp.sin(ang)
    xf = x[..., :rot_dim].astype(jnp.float32)
    x1, x2 = xf[..., :half], xf[..., half:]
    rot = jnp.concatenate([x1 * cos - x2 * sin, x2 * cos + x1 * sin], axis=-1)
    return jnp.concatenate([rot.astype(x.dtype), x[..., rot_dim:]], axis=-1)


def retention(q, k, v):
    b, h, s, dk = q.shape
    dv = v.shape[-1]
    c = RET_CHUNK
    n = s // c
    log_g = jnp.log(1.0 - jnp.power(2.0, -5.0 - jnp.arange(h, dtype=jnp.float32)))
    qf = q.astype(jnp.float32).reshape(b, h, n, c, dk)
    kf = (k.astype(jnp.float32) * (dk ** -0.5)).reshape(b, h, n, c, dk)
    vf = v.astype(jnp.float32).reshape(b, h, n, c, dv)
    idx = jnp.arange(c, dtype=jnp.float32)
    rel = idx[:, None] - idx[None, :]
    dmask = jnp.where(rel >= 0, jnp.exp(log_g[:, None, None] * jnp.maximum(rel, 0.0)), 0.0)
    scores = jnp.einsum('bhnid,bhnjd->bhnij', qf, kf) * dmask[:, None]
    inner = jnp.einsum('bhnij,bhnje->bhnie', scores, vf)
    q_dec = qf * jnp.exp(log_g[:, None] * (idx + 1.0))[:, None, :, None]
    k_dec = kf * jnp.exp(log_g[:, None] * (c - 1.0 - idx))[:, None, :, None]
    chunk_decay = jnp.exp(log_g * c)[None, :, None, None]

    def step(state, inp):
        qn, kn, vn = inp
        cross = jnp.einsum('bhid,bhde->bhie', qn, state)
        state = state * chunk_decay + jnp.einsum('bhjd,bhje->bhde', kn, vn)
        return state, cross

    xs = (jnp.moveaxis(q_dec, 2, 0), jnp.moveaxis(k_dec, 2, 0), jnp.moveaxis(vf, 2, 0))
    _, cross = lax.scan(step, jnp.zeros((b, h, dk, dv), jnp.float32), xs)
    out = inner + jnp.moveaxis(cross, 0, 2)
    return out.reshape(b, h, s, dv)


def sliding_window_attention(q, k, v, sinks):
    b, hq, s, hd = q.shape
    hkv = k.shape[1]
    g = hq // hkv
    w = WINDOW
    n = s // w
    qb = q.reshape(b, hkv, g, n, w, hd)

    def band(t):
        tb = t.reshape(b, hkv, n, w, hd)
        prev = jnp.pad(tb[:, :, :-1], ((0, 0), (0, 0), (1, 0), (0, 0), (0, 0)))
        return jnp.concatenate([prev, tb], axis=3)

    kb, vb = band(k), band(v)
    scores = jnp.einsum('bkgnqd,bknjd->bkgnqj', qb, kb).astype(jnp.float32) * (hd ** -0.5)
    qi = jnp.arange(w)[:, None]
    kj = jnp.arange(2 * w)[None, :]
    dist = qi + w - kj
    valid = (dist >= 0) & (dist < WINDOW)
    has_prev = (jnp.arange(n)[:, None, None] > 0) | (kj[None] >= w)
    mask = valid[None] & has_prev
    scores = jnp.where(mask, scores, NEG)
    sink = jnp.broadcast_to(sinks.astype(jnp.float32).reshape(1, hkv, g, 1, 1, 1), scores.shape[:-1] + (1,))
    probs = jax.nn.softmax(jnp.concatenate([scores, sink], axis=-1), axis=-1)[..., :-1]
    out = jnp.einsum('bkgnqj,bknjd->bkgnqd', probs.astype(v.dtype), vb)
    return out.reshape(b, hq, s, hd)


def memory_cross_attention(hn, memn, w_xq, w_xkv, w_xo):
    b, s, _ = hn.shape
    q = (hn @ w_xq).reshape(b, s, X_HEADS, X_HD)
    kv = (memn @ w_xkv).reshape(b, memn.shape[1], 2, X_HEADS, X_HD)
    k, v = kv[:, :, 0], kv[:, :, 1]
    scores = jnp.einsum('bshd,bmhd->bhsm', q, k).astype(jnp.float32) * (X_HD ** -0.5)
    probs = jax.nn.softmax(scores, axis=-1).astype(v.dtype)
    out = jnp.einsum('bhsm,bmhd->bshd', probs, v).reshape(b, s, X_HEADS * X_HD)
    return out @ w_xo


def setup_inputs(seed: int = 0) -> dict:
    key = jax.random.key(seed)
    ks = jax.random.split(key, 20)
    f32 = jnp.float32
    L = DEPTH

    def wt(k, shape, fan_in):
        return jax.random.normal(k, shape, f32) * (fan_in ** -0.5)

    def gain(k, shape):
        return 1.0 + 0.02 * jax.random.normal(k, shape, f32)

    return {
        'x': jax.random.normal(ks[0], (BATCH, SEQ, D_MODEL), f32),
        'mem': jax.random.normal(ks[1], (BATCH, N_MEM, D_MODEL), f32),
        'positions': jnp.broadcast_to(jnp.arange(SEQ, dtype=jnp.int32)[None, :], (BATCH, SEQ)),
        'g_mix': gain(ks[2], (L, D_MODEL)),
        'w_in': wt(ks[3], (L, D_MODEL, D_IN), D_MODEL),
        'w_up_ret': wt(ks[4], (L, RET_HEADS * RET_DV, D_MODEL), RET_HEADS * RET_DV),
        'w_up_swa': wt(ks[5], (L, SWA_HEADS * SWA_HD, D_MODEL), SWA_HEADS * SWA_HD),
        'sinks': 0.5 * jax.random.normal(ks[6], (L, SWA_HEADS), f32),
        'w_o': wt(ks[7], (L, D_MODEL, D_MODEL), D_MODEL),
        'g_x': gain(ks[8], (L, D_MODEL)),
        'g_mem': gain(ks[9], (L, D_MODEL)),
        'w_xq': wt(ks[10], (L, D_MODEL, X_HEADS * X_HD), D_MODEL),
        'w_xkv': wt(ks[11], (L, D_MODEL, 2 * X_HEADS * X_HD), D_MODEL),
        'w_xo': wt(ks[12], (L, X_HEADS * X_HD, D_MODEL), X_HEADS * X_HD),
        'g_ffn': gain(ks[13], (L, D_MODEL)),
        'w_ffn_gate': wt(ks[14], (L, D_MODEL, D_FF), D_MODEL),
        'w_ffn_up': wt(ks[15], (L, D_MODEL, D_FF), D_MODEL),
        'w_ffn_down': wt(ks[16], (L, D_FF, D_MODEL), D_FF),
        'g_final': gain(ks[17], (D_MODEL,)),
    }


def reference(x, mem, positions, g_mix, w_in, w_up_ret, w_up_swa, sinks, w_o, g_x, g_mem,
              w_xq, w_xkv, w_xo, g_ffn, w_ffn_gate, w_ffn_up, w_ffn_down, g_final):
    h = x
    offsets = [int(o) for o in np.cumsum(IN_SPLITS)[:-1]]
    for l in range(DEPTH):
        n1 = rmsnorm(h, g_mix[l])
        proj = n1 @ w_in[l]
        q_r, k_r, v_r, g_r, q_s, k_s, v_s, gate_r, gate_s = jnp.split(proj, offsets, axis=-1)
        qr = rope(to_heads(q_r, RET_HEADS), positions, RET_THETA, RET_DK)
        kr = rope(to_heads(k_r, RET_HEADS), positions, RET_THETA, RET_DK)
        yr = retention(qr, kr, to_heads(v_r, RET_HEADS))
        yr = rmsnorm(yr.transpose(0, 2, 1, 3))
        b, s = yr.shape[0], yr.shape[1]
        yr = (yr.reshape(b, s, RET_HEADS * RET_DV) * jax.nn.silu(g_r.astype(jnp.float32))).astype(h.dtype)
        qs = rope(to_heads(q_s, SWA_HEADS), positions, ROPE_THETA, ROPE_DIM)
        ksw = rope(to_heads(k_s, SWA_KV_HEADS), positions, ROPE_THETA, ROPE_DIM)
        ys = sliding_window_attention(qs, ksw, to_heads(v_s, SWA_KV_HEADS), sinks[l])
        ys = ys.transpose(0, 2, 1, 3).reshape(b, s, SWA_HEADS * SWA_HD)
        merged = jax.nn.sigmoid(gate_r) * (yr @ w_up_ret[l]) + jax.nn.sigmoid(gate_s) * (ys @ w_up_swa[l])
        h = h + merged @ w_o[l]
        h = h + memory_cross_attention(rmsnorm(h, g_x[l]), rmsnorm(mem, g_mem[l]), w_xq[l], w_xkv[l], w_xo[l])
        n2 = rmsnorm(h, g_ffn[l])
        h = h + (jax.nn.silu(n2 @ w_ffn_gate[l]) * (n2 @ w_ffn_up[l])) @ w_ffn_down[l]
    return rmsnorm(h, g_final)
```

```cpp
#include <hip/hip_runtime.h>
#include <cstdio>
#include <cstdint>
namespace pg8 {
#define PG8_LAS __attribute__((address_space(3)))
typedef unsigned short bf16_t;
typedef short bf16x8 __attribute__((ext_vector_type(8)));
typedef float f32x4 __attribute__((ext_vector_type(4)));
typedef unsigned u32x4 __attribute__((ext_vector_type(4)));
constexpr int BM = 256, BK = 64, HALF = 128, HTB = HALF * BK * 2  , STAGE_BYTES = 8 * HTB, NXCD = 8, WGM = 8;

__host__ __device__ __forceinline__ int lds_byte(int r, int c) { const int st = (r >> 4) * 2 + (c >> 5), rr = r & 15, cc = c & 31, ob = rr * 64 + cc * 2; return st * 1024 + (ob ^ (((ob >> 9) & 1) << 5)); }
__host__ __device__ __forceinline__ void stage_rc(int b, int& R, int& C) { const int st = b / 1024, sb = b % 1024, swz = sb ^ (((sb >> 9) & 1) << 5); R = (st >> 1) * 16 + swz / 64; C = (st & 1) * 32 + (swz % 64) / 2; }
__host__ __device__ __forceinline__ int perm32(int rho) { const int n = rho >> 4, i = rho & 15; return 8 * (i >> 2) + 4 * n + (i & 3); }

struct Unit { int pm, pn; };
struct Gemm { const bf16_t* A; const bf16_t* Bt; int M, N, K; };

struct StaticOrder {
    int nM, nN, nwg, G, c;
    __host__ __device__ void init(int M, int N, int G_, int c_) { nM = M / BM; nN = N / BM; nwg = nM * nN; G = G_; c = c_; }
    __host__ __device__ bool next(int i, Unit& u) const {
        const long L = (long)i * G + c; if (L >= nwg) return false;
        int wgid = (int)L; { const int q = nwg / NXCD, r = nwg % NXCD, xcd = wgid % NXCD, off = wgid / NXCD; wgid = (xcd < r ? xcd * (q + 1) : r * (q + 1) + (xcd - r) * q) + off; }
        const int nig = WGM * nN, gid = wgid / nig, fm = gid * WGM, gsz = (nM - fm) < WGM ? (nM - fm) : WGM;
        u.pm = fm + ((wgid % nig) % gsz); u.pn = (wgid % nig) / gsz; return true;
    }
    __device__ __forceinline__ void a_ready(const Unit&) const {}
    __device__ __forceinline__ void done(const Unit&) const {}
};

__device__ __forceinline__ unsigned cvt_pk_bf16(float lo, float hi) { unsigned r; asm volatile("v_cvt_pk_bf16_f32 %0, %1, %2" : "=v"(r) : "v"(lo), "v"(hi)); return r; }
typedef float f32x2 __attribute__((ext_vector_type(2)));
template <class Epi, class Sched, bool ALIGN_EPI = false, bool SP2 = false>
__device__ __forceinline__ void gemm_phase(PG8_LAS unsigned char* lds, const Gemm g, const Sched& S, const Epi& E) {
    int tid_ = threadIdx.x; asm volatile("" : "+v"(tid_));
    const int tid = tid_, wid = __builtin_amdgcn_readfirstlane(tid >> 6), lane = tid & 63, wr = wid >> 2, wc = wid & 3, fr = lane & 15, fq = lane >> 4;
    const int K = g.K, nt = K / BK;
    unsigned voffA[2], voffB[2];
#pragma unroll
    for (int i = 0; i < 2; ++i) { int R, C; stage_rc(tid * 16 + i * 8192, R, C); const int Rb = Epi::PERM ? ((R & ~31) + perm32(R & 31)) : R;
        voffA[i] = (unsigned)(R * K + C) * 2u; voffB[i] = (unsigned)(Rb * K + C) * 2u; }
    const size_t kstep = (size_t)(BK * 2);
    const size_t hstep = (size_t)HALF * K * 2;
    const size_t tstep = 2 * hstep;
    const unsigned ldsw = (unsigned)wid * 1024u;
    const int aoff = lds_byte(wr * 64 + fr, fq * 8), boff = lds_byte(wc * 32 + fr, fq * 8);
#define PG8_SA(b, h) (((b) * 2 + (h)) * HTB)
#define PG8_SB(b, h) ((4 + (b) * 2 + (h)) * HTB)
#define PG8_STAGE(bufoff, gbase, voff) do { _Pragma("unroll") for (int _i = 0; _i < 2; ++_i) \
        __builtin_amdgcn_global_load_lds((const unsigned*)((const char*)(gbase) + (voff)[_i]), (PG8_LAS unsigned*)(lds + (bufoff) + ldsw + _i * 8192), 16, 0, 0); } while (0)
#define PG8_LDA(dst, b, h) do { _Pragma("unroll") for (int m = 0; m < 4; ++m) _Pragma("unroll") for (int k = 0; k < 2; ++k) dst[m][k] = *(const PG8_LAS bf16x8*)(lds + PG8_SA(b, h) + aoff + m * 2048 + k * 1024); } while (0)
#define PG8_LDB(dst, b, h) do { _Pragma("unroll") for (int n = 0; n < 2; ++n) _Pragma("unroll") for (int k = 0; k < 2; ++k) dst[n][k] = *(const PG8_LAS bf16x8*)(lds + PG8_SB(b, h) + boff + n * 2048 + k * 1024); } while (0)
#define PG8_MMA(ai, bj, At, Bt) do { __builtin_amdgcn_s_setprio(1); _Pragma("unroll") for (int m = 0; m < 4; ++m) _Pragma("unroll") for (int n = 0; n < 2; ++n) _Pragma("unroll") for (int k = 0; k < 2; ++k) \
        acc[ai][bj][m][n] = __builtin_amdgcn_mfma_f32_16x16x32_bf16(Bt[n][k], At[m][k], acc[ai][bj][m][n], 0, 0, 0); __builtin_amdgcn_s_setprio(0); } while (0)
#define PG8_WAIT_V(n) asm volatile("s_waitcnt vmcnt(" #n ")" ::: "memory")
#define PG8_WAIT_L(n) asm volatile("s_waitcnt lgkmcnt(" #n ")" ::: "memory")
#define PG8_BAR __builtin_amdgcn_s_barrier()
#define PG8_SCHED __builtin_amdgcn_sched_barrier(0)
    Unit cur, nxt; int ui = 0;
    if (!S.next(0, cur)) return;
    f32x4 acc[2][2][4][2];
#pragma unroll
    for (int a = 0; a < 2; ++a)
#pragma unroll
        for (int b = 0; b < 2; ++b)
#pragma unroll
            for (int m = 0; m < 4; ++m)
#pragma unroll
                for (int n = 0; n < 2; ++n) acc[a][b][m][n] = (f32x4){0.f, 0.f, 0.f, 0.f};
    bf16x8 At[4][2], B0[2][2], B1[2][2];
    const char* cA = (const char*)g.A + (size_t)cur.pm * tstep; const char* cB = (const char*)g.Bt + (size_t)cur.pn * tstep;
    S.a_ready(cur);
    if constexpr (SP2) {
        PG8_STAGE(PG8_SB(0, 0), cB, voffB); PG8_STAGE(PG8_SB(0, 1), cB + hstep, voffB); PG8_STAGE(PG8_SA(0, 0), cA, voffA); PG8_STAGE(PG8_SA(0, 1), cA + hstep, voffA);
        if (wr == 1) PG8_BAR;
        PG8_WAIT_V(2); PG8_BAR;
        PG8_STAGE(PG8_SB(1, 0), cB + kstep, voffB); PG8_STAGE(PG8_SA(1, 0), cA + kstep, voffA); PG8_STAGE(PG8_SB(1, 1), cB + hstep + kstep, voffB);
        PG8_WAIT_V(6); PG8_BAR;
    } else {
        PG8_STAGE(PG8_SB(0, 0), cB, voffB); PG8_STAGE(PG8_SA(0, 0), cA, voffA); PG8_STAGE(PG8_SB(0, 1), cB + hstep, voffB); PG8_STAGE(PG8_SA(0, 1), cA + hstep, voffA);
        if (wr == 1) PG8_BAR;
        PG8_WAIT_V(4); PG8_BAR;
        PG8_STAGE(PG8_SB(1, 0), cB + kstep, voffB); PG8_STAGE(PG8_SA(1, 0), cA + kstep, voffA); PG8_STAGE(PG8_SB(1, 1), cB + hstep + kstep, voffB);
        PG8_WAIT_V(6); PG8_BAR;
    }
    for (;;) {
        const bool has_next = S.next(ui + 1, nxt);
        const char* nA = has_next ? (const char*)g.A + (size_t)nxt.pm * tstep : cA; const char* nB = has_next ? (const char*)g.Bt + (size_t)nxt.pn * tstep : cB;
        for (int t = 0; t < nt; t += 2) {
            const bool last = (t == nt - 2);
            const char* a1 = cA + (size_t)(t + 1) * kstep;
            const char* a2 = last ? nA : cA + (size_t)(t + 2) * kstep; const char* b2 = last ? nB : cB + (size_t)(t + 2) * kstep;
            const char* a3 = a2 + kstep; const char* b3 = b2 + kstep;
            if (last && has_next) S.a_ready(nxt);
            if constexpr (SP2) {
            PG8_LDB(B0, 0, 0); PG8_LDB(B1, 0, 1); PG8_SCHED; PG8_LDA(At, 0, 0); PG8_STAGE(PG8_SA(1, 1), a1 + hstep, voffA);
            PG8_WAIT_V(8); PG8_WAIT_L(0); PG8_BAR; PG8_MMA(0, 0, At, B0); PG8_MMA(0, 1, At, B1); PG8_BAR; PG8_SCHED;
            PG8_LDA(At, 0, 1); PG8_STAGE(PG8_SB(0, 0), b2, voffB); PG8_STAGE(PG8_SB(0, 1), b2 + hstep, voffB); PG8_STAGE(PG8_SA(0, 0), a2, voffA);
            PG8_WAIT_V(8); PG8_WAIT_L(0); PG8_BAR; PG8_MMA(1, 0, At, B0); PG8_MMA(1, 1, At, B1); PG8_BAR; PG8_SCHED;
            PG8_LDB(B0, 1, 0); PG8_LDB(B1, 1, 1); PG8_SCHED; PG8_LDA(At, 1, 0); PG8_STAGE(PG8_SA(0, 1), a2 + hstep, voffA);
            PG8_WAIT_V(8); PG8_WAIT_L(0); PG8_BAR; PG8_MMA(0, 0, At, B0); PG8_MMA(0, 1, At, B1); PG8_BAR; PG8_SCHED;
            PG8_LDA(At, 1, 1); PG8_STAGE(PG8_SB(1, 0), b3, voffB); PG8_STAGE(PG8_SB(1, 1), b3 + hstep, voffB); PG8_STAGE(PG8_SA(1, 0), a3, voffA);
            PG8_WAIT_V(8); PG8_WAIT_L(0); PG8_BAR; PG8_MMA(1, 0, At, B0); PG8_MMA(1, 1, At, B1); PG8_BAR; PG8_SCHED;
            } else {
            PG8_LDB(B0, 0, 0); PG8_SCHED; PG8_LDA(At, 0, 0); PG8_STAGE(PG8_SA(1, 1), a1 + hstep, voffA);
            PG8_WAIT_L(8); PG8_BAR; PG8_WAIT_L(0); PG8_MMA(0, 0, At, B0); PG8_BAR; PG8_SCHED;
            PG8_LDB(B1, 0, 1); PG8_STAGE(PG8_SB(0, 0), b2, voffB);
            PG8_BAR; PG8_WAIT_L(0); PG8_MMA(0, 1, At, B1); PG8_BAR;
            PG8_LDA(At, 0, 1); PG8_STAGE(PG8_SA(0, 0), a2, voffA);
            PG8_BAR; PG8_WAIT_L(0); PG8_MMA(1, 0, At, B0); PG8_BAR; PG8_SCHED;
            PG8_STAGE(PG8_SB(0, 1), b2 + hstep, voffB);
            PG8_WAIT_V(6); PG8_BAR; PG8_MMA(1, 1, At, B1); PG8_BAR;
            PG8_LDB(B0, 1, 0); PG8_SCHED; PG8_LDA(At, 1, 0); PG8_STAGE(PG8_SA(0, 1), a2 + hstep, voffA);
            PG8_WAIT_L(8); PG8_BAR; PG8_WAIT_L(0); PG8_MMA(0, 0, At, B0); PG8_BAR; PG8_SCHED;
            PG8_LDB(B1, 1, 1); PG8_STAGE(PG8_SB(1, 0), b3, voffB);
            PG8_BAR; PG8_WAIT_L(0); PG8_MMA(0, 1, At, B1); PG8_BAR;
            PG8_LDA(At, 1, 1); PG8_STAGE(PG8_SA(1, 0), a3, voffA);
            PG8_BAR; PG8_WAIT_L(0); PG8_MMA(1, 0, At, B0); PG8_BAR; PG8_SCHED;
            PG8_STAGE(PG8_SB(1, 1), b3 + hstep, voffB);
            PG8_WAIT_V(6); PG8_BAR; PG8_MMA(1, 1, At, B1); PG8_BAR;
            }
        }
        if constexpr (ALIGN_EPI) { if (wr == 0) PG8_BAR; }
        if constexpr (!Epi::AFTER_DRAIN) { E(acc, cur, wr, wc, fr, fq); S.done(cur); }
        if (!has_next) break;
#pragma unroll
        for (int a = 0; a < 2; ++a)
#pragma unroll
            for (int b = 0; b < 2; ++b)
#pragma unroll
                for (int m = 0; m < 4; ++m)
#pragma unroll
                    for (int n = 0; n < 2; ++n) acc[a][b][m][n] = (f32x4){0.f, 0.f, 0.f, 0.f};
        cur = nxt; cA = nA; cB = nB; ++ui;
        if constexpr (ALIGN_EPI) { if (wr == 1) PG8_BAR; }
    }
    PG8_WAIT_V(0);
    if constexpr (!ALIGN_EPI) { if (wr == 0) PG8_BAR; }
    PG8_BAR;
    if constexpr (Epi::AFTER_DRAIN) { E.fused(acc, cur, wr, wc, fr, fq, lds, wid, lane); S.done(cur); }
#undef PG8_SA
#undef PG8_SB
#undef PG8_STAGE
#undef PG8_LDA
#undef PG8_LDB
#undef PG8_MMA
#undef PG8_WAIT_V
#undef PG8_WAIT_L
#undef PG8_BAR
#undef PG8_SCHED
}
}

#ifndef PG8_SP2
#define PG8_SP2 true
#endif
#ifndef PG8_ALIGN
#define PG8_ALIGN true
#endif
#define GAS __attribute__((address_space(1)))
#define LAS __attribute__((address_space(3)))
typedef unsigned short bf16;
typedef unsigned v4u __attribute__((ext_vector_type(4)));
typedef float f32x4 __attribute__((ext_vector_type(4)));
typedef short bf16x8 __attribute__((ext_vector_type(8)));
typedef GAS unsigned gu32;
typedef GAS unsigned long long gu64;
#define RLX_AGENT __ATOMIC_RELAXED, __HIP_MEMORY_SCOPE_AGENT
#define LDS_WAIT() asm volatile("s_waitcnt lgkmcnt(0)" ::: "memory")
#define VM_WAIT() asm volatile("s_waitcnt vmcnt(0)" ::: "memory")
__device__ __forceinline__ unsigned long long rt() { return __builtin_amdgcn_s_memrealtime(); }
__device__ __forceinline__ unsigned f2bf(float f) { unsigned u = __builtin_bit_cast(unsigned, f); return (u + 0x7fffu + ((u >> 16) & 1u)) >> 16; }
__device__ __forceinline__ unsigned pk2(float lo, float hi) { return f2bf(lo) | (f2bf(hi) << 16); }

#define XB_TMO      128
#define XB_XCNT(j)  (256  + 64 * (j))
#define XB_XSUB(j)  (1280 + 64 * (j))
#define XB_XGEN(j)  (2304 + 64 * (j))
#define XB_TOP      3328
#define XB_TOPGEN   3392
#define XCD_BAR_WORDS 3456
#define XB_SPIN_CAP (1u << 22)

__device__ __forceinline__ unsigned xb_ld(unsigned* p)              { return __hip_atomic_load(p, __ATOMIC_RELAXED, __HIP_MEMORY_SCOPE_AGENT); }
__device__ __forceinline__ unsigned xb_add(unsigned* p, unsigned v) { return __hip_atomic_fetch_add(p, v, __ATOMIC_RELAXED, __HIP_MEMORY_SCOPE_AGENT); }
__device__ __forceinline__ unsigned xb_xcc_id() { return (unsigned)__builtin_amdgcn_s_getreg((3 << 11) | 20) & 0xFu; }
#define XB_SPIN(cond, bar) do { unsigned _sp = 0; while (cond) { __builtin_amdgcn_s_sleep(1); \
    if ((++_sp & 255u) == 0u) { if (xb_ld(&(bar)[XB_TMO])) break; if (_sp > XB_SPIN_CAP) { atomicAdd(&(bar)[XB_TMO], 1u); break; } } } } while (0)

struct XcdBarrier {
    unsigned* bar; unsigned x;
    volatile LAS unsigned* st;
};

__device__ __forceinline__ XcdBarrier xcd_barrier_post(unsigned* bar, volatile LAS unsigned* st) {
    XcdBarrier b; b.bar = bar; b.x = xb_xcc_id(); b.st = st;
    if (threadIdx.x == 0) (void)xb_add(&bar[XB_XCNT(b.x)], 1u);
    return b;
}
__device__ __forceinline__ void xcd_barrier_complete(unsigned* bar, unsigned x, unsigned& nloc, unsigned& nx) {
    const unsigned G = gridDim.x * gridDim.y * gridDim.z;
    unsigned sum, cnt, mine, sp = 0u;
    for (;;) {
        sum = 0u; cnt = 0u; mine = 0u;
#pragma unroll
        for (unsigned j = 0; j < 16; ++j) { const unsigned c = xb_ld(&bar[XB_XCNT(j)]); sum += c; cnt += (c > 0u) ? 1u : 0u; mine = (j == x) ? c : mine; }
        if (sum == G) break;
        __builtin_amdgcn_s_sleep(1);
        if ((++sp & 255u) == 0u) { if (xb_ld(&bar[XB_TMO])) break; if (sp > XB_SPIN_CAP) { atomicAdd(&bar[XB_TMO], 1u); break; } }
    }
    nloc = mine > 0u ? mine : 1u; nx = cnt > 0u ? cnt : 1u;
}

__device__ __forceinline__ void xcd_barrier(const XcdBarrier& b) {
    asm volatile("s_waitcnt vmcnt(0)" ::: "memory");
    __syncthreads();
    if (threadIdx.x == 0) {
        unsigned* bar = b.bar;
        __builtin_amdgcn_s_waitcnt(0);
        unsigned nloc = b.st[0], nx = b.st[1];
        if (nloc == 0u) { xcd_barrier_complete(bar, b.x, nloc, nx); b.st[0] = nloc; b.st[1] = nx; }
        const unsigned old = xb_add(&bar[XB_XSUB(b.x)], 1u);
        const unsigned gen = old / nloc;
        if (old + 1u == (gen + 1u) * nloc) {
            __builtin_amdgcn_fence(__ATOMIC_RELEASE, "agent");
            asm volatile("s_waitcnt vmcnt(0)" ::: "memory");
            const unsigned og = xb_add(&bar[XB_TOP], 1u);
            const unsigned tg = og / nx;
            if (og + 1u == (tg + 1u) * nx) xb_add(&bar[XB_TOPGEN], 1u);
            else XB_SPIN(xb_ld(&bar[XB_TOPGEN]) == tg, bar);
            __builtin_amdgcn_fence(__ATOMIC_ACQUIRE, "agent");
            xb_add(&bar[XB_XGEN(b.x)], 1u);
            asm volatile("s_waitcnt vmcnt(0)" ::: "memory");
        } else {
            XB_SPIN(xb_ld(&bar[XB_XGEN(b.x)]) == gen, bar);
            __builtin_amdgcn_fence(__ATOMIC_ACQUIRE, "agent");
            asm volatile("s_waitcnt vmcnt(0)" ::: "memory");
        }
    }
    __syncthreads();
}

constexpr int NWAVES = 8;
constexpr int M = 16384, D = 2048, NIN = 9728, DFF = 5632, NMEM = 256;
constexpr float EPS = 1e-6f;
constexpr size_t MiB = 1u << 20;
constexpr size_t WS_CTL = 0, CTL_ZERO_BYTES = 1 * MiB;
constexpr size_t WS_SSQ1 = 1 * MiB, WS_SSQ2 = 3 * MiB, WS_SSQ3 = 5 * MiB;
constexpr size_t WS_MEMN = 7 * MiB;
constexpr size_t WS_KVM = 8 * MiB;
constexpr size_t WS_COSS = 9 * MiB, WS_SINS = 9 * MiB + 512 * 1024;
constexpr size_t WS_COSR = 10 * MiB, WS_SINR = 18 * MiB;
constexpr size_t WS_W = 26 * MiB;
constexpr size_t W_IN = WS_W, W_UR = WS_W + 38 * MiB, W_US = WS_W + 42 * MiB, W_O = WS_W + 46 * MiB, W_XQ = WS_W + 54 * MiB,
                 W_XKV = WS_W + 56 * MiB, W_XO = WS_W + 60 * MiB, W_GU = WS_W + 62 * MiB, W_DN = WS_W + 106 * MiB;
constexpr size_t WS_ACT = 154 * MiB;
constexpr size_t A_QR = WS_ACT + 0 * MiB, A_QS = WS_ACT + 32 * MiB, A_KR = WS_ACT + 64 * MiB, A_KD = WS_ACT + 96 * MiB, A_VR = WS_ACT + 128 * MiB,
                 A_GR = WS_ACT + 160 * MiB, A_KS = WS_ACT + 192 * MiB, A_VS = WS_ACT + 200 * MiB, A_SGR = WS_ACT + 208 * MiB, A_SGS = WS_ACT + 272 * MiB;
constexpr size_t A_MERGED = WS_ACT + 64 * MiB, A_H1B = WS_ACT + 128 * MiB, A_XQ = WS_ACT + 0 * MiB, A_XA = WS_ACT + 16 * MiB, A_H2B = WS_ACT + 64 * MiB,
                 A_ACTF = WS_ACT + 160 * MiB;
constexpr size_t WS_END = 490 * MiB;
static_assert(A_ACTF + (size_t)M * DFF * 2 <= WS_END && WS_END <= 512 * MiB, "d_ws map");
constexpr int CW_BAR = 4096;
constexpr int RING_OFF = 0, RING_BYTES = 131072;
constexpr int LDSCTL_OFF = RING_BYTES, MISC_OFF = LDSCTL_OFF + 320;
constexpr int LDS_BYTES = 147456;

typedef pg8::f32x4 f4;
typedef unsigned u4 __attribute__((ext_vector_type(4)));
typedef unsigned u2 __attribute__((ext_vector_type(2)));
__device__ __forceinline__ float bf2f(unsigned short b) { return __uint_as_float((unsigned)b << 16); }
__device__ __forceinline__ float bflo(unsigned w) { return __uint_as_float(w << 16); }
__device__ __forceinline__ float bfhi(unsigned w) { return __uint_as_float(w & 0xffff0000u); }
__device__ __forceinline__ float wave_sum(float v) {
#pragma unroll
    for (int o = 1; o < 64; o <<= 1) v += __shfl_xor(v, o);
    return v;
}
__device__ __forceinline__ float wave_max(float v) {
#pragma unroll
    for (int o = 1; o < 64; o <<= 1) v = fmaxf(v, __shfl_xor(v, o));
    return v;
}
__device__ __forceinline__ float sigmoidf_(float v) { return 1.0f / (1.0f + __expf(-v)); }
__device__ __forceinline__ u4 pack8(const f4& a, const f4& b) {
    u4 w; w.x = pg8::cvt_pk_bf16(a[0], a[1]); w.y = pg8::cvt_pk_bf16(a[2], a[3]); w.z = pg8::cvt_pk_bf16(b[0], b[1]); w.w = pg8::cvt_pk_bf16(b[2], b[3]); return w;
}
__device__ __forceinline__ float log2_gamma(int h) {
    return h == 0 ? -0.045803689613124704f : h == 1 ? -0.022720076500083645f : h == 2 ? -0.011315313227834157f : -0.005646563141142062f;
}

__device__ __forceinline__ void p0_transpose_item(const float* W, int K, int N, bf16* WT, int kb, int nb, int drow0, const float* gk, LAS float* scr, int lane) {
    const int k0 = 64 * kb, n0 = 32 * nb;
#pragma unroll 8
    for (int i = 0; i < 32; ++i) { const int kk = 2 * i + (lane >> 5); float w = W[(size_t)(k0 + kk) * N + n0 + (lane & 31)]; if (gk) w *= gk[k0 + kk]; scr[kk * 33 + (lane & 31)] = w; }
    LDS_WAIT(); asm volatile("" ::: "memory");
    const int c = lane & 7;
#pragma unroll
    for (int j = 0; j < 4; ++j) { const int n = (lane >> 3) + 8 * j; const LAS float* s = scr + (8 * c) * 33 + n;
        v4u o; o.x = pk2(s[0 * 33], s[1 * 33]); o.y = pk2(s[2 * 33], s[3 * 33]); o.z = pk2(s[4 * 33], s[5 * 33]); o.w = pk2(s[6 * 33], s[7 * 33]);
        *(GAS v4u*)(WT + (size_t)(drow0 + n) * K + k0 + 8 * c) = o; }
    LDS_WAIT(); asm volatile("" ::: "memory");
}
__device__ __forceinline__ void rms_row_to_bf16(const float* xrow, const float* g, bf16* orow, int lane) {
    const GAS f4* xr = (const GAS f4*)xrow + lane; const GAS f4* gr = (const GAS f4*)g + lane;
    f4 v[8]; float s = 0.f;
#pragma unroll
    for (int j = 0; j < 8; ++j) { v[j] = xr[64 * j]; s += (v[j].x * v[j].x + v[j].y * v[j].y) + (v[j].z * v[j].z + v[j].w * v[j].w); }
    const float rstd = 1.0f / sqrtf(wave_sum(s) * (1.f / 2048.f) + EPS);
    GAS unsigned long long* o8 = (GAS unsigned long long*)orow + lane;
#pragma unroll
    for (int j = 0; j < 8; ++j) { const f4 gg = gr[64 * j]; o8[64 * j] = (unsigned long long)pk2(v[j].x * rstd * gg.x, v[j].y * rstd * gg.y) | ((unsigned long long)pk2(v[j].z * rstd * gg.z, v[j].w * rstd * gg.w) << 32); }
}

struct EpiInProj {
    static constexpr bool PERM = true, AFTER_DRAIN = false;
    unsigned char* ws;
    __device__ __forceinline__ void operator()(const f4 (&acc)[2][2][4][2], const pg8::Unit& u, int wr, int wc, int fr, int fq) const {
        const int pn = u.pn, cl = wc * 32 + 8 * fq, row0 = u.pm * 256 + wr * 64 + fr;
        const float* cosr = (const float*)(ws + WS_COSR); const float* sinr = (const float*)(ws + WS_SINR);
        const float* coss = (const float*)(ws + WS_COSS); const float* sins = (const float*)(ws + WS_SINS);
        if (pn < 8) {
            const bool isk = pn >= 4; const int hh = pn & 3;
            bf16* dst = (bf16*)(ws + (isk ? A_KR : A_QR)); bf16* dkd = (bf16*)(ws + A_KD);
            const float l2g = log2_gamma(hh);
#pragma unroll
            for (int ai = 0; ai < 2; ++ai)
#pragma unroll
                for (int m = 0; m < 4; ++m) { const int row = row0 + ai * 128 + m * 16;
                    const f4 c0 = *(const f4*)(cosr + (size_t)row * 128 + cl), c1 = *(const f4*)(cosr + (size_t)row * 128 + cl + 4);
                    const f4 s0 = *(const f4*)(sinr + (size_t)row * 128 + cl), s1 = *(const f4*)(sinr + (size_t)row * 128 + cl + 4);
                    const f4 a0 = acc[ai][0][m][0], a1 = acc[ai][0][m][1], b0 = acc[ai][1][m][0], b1 = acc[ai][1][m][1];
                    f4 y0 = a0 * c0 - b0 * s0, y1 = a1 * c1 - b1 * s1, z0 = b0 * c0 + a0 * s0, z1 = b1 * c1 + a1 * s1;
                    if (isk) { y0 = y0 * 0.0625f; y1 = y1 * 0.0625f; z0 = z0 * 0.0625f; z1 = z1 * 0.0625f; }
                    bf16* p = dst + (size_t)row * 1024 + hh * 256 + cl;
                    *(u4*)p = pack8(y0, y1); *(u4*)(p + 128) = pack8(z0, z1);
                    if (isk) { const float dec = exp2f((float)(127 - (row & 127)) * l2g);
                        bf16* q = dkd + (size_t)row * 1024 + hh * 256 + cl;
                        *(u4*)q = pack8(y0 * dec, y1 * dec); *(u4*)(q + 128) = pack8(z0 * dec, z1 * dec); } }
        } else if (pn < 16 || pn >= 21) {
            bf16* dst; int ld, colb, mode;
            if (pn < 12) { dst = (bf16*)(ws + A_VR); ld = 1024; colb = (pn - 8) * 256; mode = 0; }
            else if (pn < 16) { dst = (bf16*)(ws + A_GR); ld = 1024; colb = (pn - 12) * 256; mode = 1; }
            else if (pn == 21) { dst = (bf16*)(ws + A_VS); ld = 256; colb = 0; mode = 0; }
            else if (pn < 30) { dst = (bf16*)(ws + A_SGR); ld = 2048; colb = (pn - 22) * 256; mode = 2; }
            else { dst = (bf16*)(ws + A_SGS); ld = 2048; colb = (pn - 30) * 256; mode = 2; }
#pragma unroll
            for (int ai = 0; ai < 2; ++ai)
#pragma unroll
                for (int m = 0; m < 4; ++m) { const int row = row0 + ai * 128 + m * 16;
#pragma unroll
                    for (int bj = 0; bj < 2; ++bj) { f4 v0 = acc[ai][bj][m][0], v1 = acc[ai][bj][m][1];
                        if (mode != 0) {
#pragma unroll
                            for (int e = 0; e < 4; ++e) { const float g0 = sigmoidf_(v0[e]), g1 = sigmoidf_(v1[e]); v0[e] = mode == 1 ? v0[e] * g0 : g0; v1[e] = mode == 1 ? v1[e] * g1 : g1; } }
                        *(u4*)(dst + (size_t)row * ld + colb + bj * 128 + cl) = pack8(v0, v1); } }
        } else {
            const bool isq = pn < 20;
            bf16* dst = (bf16*)(ws + (isq ? A_QS : A_KS)); const int ld = isq ? 1024 : 256, colb = isq ? (pn - 16) * 256 : 0;
            const int hc = cl & 63;
            const float sc = isq ? 0.125f : 1.0f;
            const float fc = (hc < 16) ? 1.f : 0.f, fs = (hc == 0) ? -1.f : (hc == 8) ? 1.f : 0.f;
#pragma unroll
            for (int ai = 0; ai < 2; ++ai)
#pragma unroll
                for (int m = 0; m < 4; ++m) { const int row = row0 + ai * 128 + m * 16;
                    const f4 c0 = *(const f4*)(coss + (size_t)row * 8), c1 = *(const f4*)(coss + (size_t)row * 8 + 4);
                    const f4 s0 = *(const f4*)(sins + (size_t)row * 8), s1 = *(const f4*)(sins + (size_t)row * 8 + 4);
#pragma unroll
                    for (int bj = 0; bj < 2; ++bj) { f4 v0 = acc[ai][bj][m][0], v1 = acc[ai][bj][m][1]; f4 p0, p1;
#pragma unroll
                        for (int e = 0; e < 4; ++e) { p0[e] = __shfl_xor(v0[e], 16); p1[e] = __shfl_xor(v1[e], 16); }
                        v0 = v0 * ((c0 - 1.f) * fc + 1.f) + p0 * (s0 * fs); v1 = v1 * ((c1 - 1.f) * fc + 1.f) + p1 * (s1 * fs);
                        v0 = v0 * sc; v1 = v1 * sc;
                        *(u4*)(dst + (size_t)row * ld + colb + bj * 128 + cl) = pack8(v0, v1); } }
        }
    }
};
struct EpiPlain {
    static constexpr bool PERM = true, AFTER_DRAIN = false;
    bf16* O; int ldc;
    __device__ __forceinline__ void operator()(const f4 (&acc)[2][2][4][2], const pg8::Unit& u, int wr, int wc, int fr, int fq) const {
        const int cl = wc * 32 + 8 * fq, row0 = u.pm * 256 + wr * 64 + fr;
#pragma unroll
        for (int ai = 0; ai < 2; ++ai)
#pragma unroll
            for (int m = 0; m < 4; ++m) { const int row = row0 + ai * 128 + m * 16;
#pragma unroll
                for (int bj = 0; bj < 2; ++bj) *(u4*)(O + (size_t)row * ldc + u.pn * 256 + bj * 128 + cl) = pack8(acc[ai][bj][m][0], acc[ai][bj][m][1]); }
    }
};
struct EpiUp {
    static constexpr bool PERM = true, AFTER_DRAIN = false;
    unsigned char* ws;
    __device__ __forceinline__ void operator()(const f4 (&acc)[2][2][4][2], const pg8::Unit& u, int wr, int wc, int fr, int fq) const {
        const int w = u.pm >= 64 ? 1 : 0, pm = u.pm & 63, pn = u.pn & 7;
        const int cl = wc * 32 + 8 * fq, row0 = pm * 256 + wr * 64 + fr;
        const bf16* gate = (const bf16*)(ws + (w ? A_SGS : A_SGR)); bf16* mg = (bf16*)(ws + A_MERGED);
#pragma unroll
        for (int ai = 0; ai < 2; ++ai)
#pragma unroll
            for (int m = 0; m < 4; ++m) { const int row = row0 + ai * 128 + m * 16;
#pragma unroll
                for (int bj = 0; bj < 2; ++bj) { const size_t off = (size_t)row * 2048 + pn * 256 + bj * 128 + cl;
                    const u4 g = *(const u4*)(gate + off); f4 v0 = acc[ai][bj][m][0], v1 = acc[ai][bj][m][1];
                    v0[0] *= bflo(g.x); v0[1] *= bfhi(g.x); v0[2] *= bflo(g.y); v0[3] *= bfhi(g.y); v1[0] *= bflo(g.z); v1[1] *= bfhi(g.z); v1[2] *= bflo(g.w); v1[3] *= bfhi(g.w);
                    if (w) { const u4 p = *(const u4*)(mg + off);
                        v0[0] += bflo(p.x); v0[1] += bfhi(p.x); v0[2] += bflo(p.y); v0[3] += bfhi(p.y); v1[0] += bflo(p.z); v1[1] += bfhi(p.z); v1[2] += bflo(p.w); v1[3] += bfhi(p.w); }
                    *(u4*)(mg + off) = pack8(v0, v1); } }
    }
};
struct EpiResid {
    static constexpr bool PERM = true, AFTER_DRAIN = false;
    const float* base; float* out; bf16* hb; float* ssq;
    __device__ __forceinline__ void operator()(const f4 (&acc)[2][2][4][2], const pg8::Unit& u, int wr, int wc, int fr, int fq) const {
        const int cl = wc * 32 + 8 * fq, row0 = u.pm * 256 + wr * 64 + fr;
#pragma unroll
        for (int ai = 0; ai < 2; ++ai)
#pragma unroll
            for (int m = 0; m < 4; ++m) { const int row = row0 + ai * 128 + m * 16; float ss = 0.f;
#pragma unroll
                for (int bj = 0; bj < 2; ++bj) { const size_t off = (size_t)row * 2048 + u.pn * 256 + bj * 128 + cl;
                    const f4 x0 = *(const f4*)(base + off), x1 = *(const f4*)(base + off + 4);
                    const f4 h0 = x0 + acc[ai][bj][m][0], h1 = x1 + acc[ai][bj][m][1];
                    *(f4*)(out + off) = h0; *(f4*)(out + off + 4) = h1;
                    if (hb) *(u4*)(hb + off) = pack8(h0, h1);
                    ss += (h0[0] * h0[0] + h0[1] * h0[1]) + (h0[2] * h0[2] + h0[3] * h0[3]) + (h1[0] * h1[0] + h1[1] * h1[1]) + (h1[2] * h1[2] + h1[3] * h1[3]); }
                ss += __shfl_xor(ss, 16); ss += __shfl_xor(ss, 32);
                if (fq == 0) ssq[(size_t)row * 32 + u.pn * 4 + wc] = ss; }
    }
};
__device__ __forceinline__ float row_rstd(const float* ssq, int row) {
    const f4* p = (const f4*)(ssq + (size_t)row * 32); float s = 0.f;
#pragma unroll
    for (int i = 0; i < 8; ++i) { const f4 v = p[i]; s += (v[0] + v[1]) + (v[2] + v[3]); }
    return 1.0f / sqrtf(s * (1.f / 2048.f) + EPS);
}
struct EpiRstd {
    static constexpr bool PERM = true, AFTER_DRAIN = false;
    bf16* O; int ldc; const float* ssq;
    __device__ __forceinline__ void operator()(const f4 (&acc)[2][2][4][2], const pg8::Unit& u, int wr, int wc, int fr, int fq) const {
        const int cl = wc * 32 + 8 * fq, row0 = u.pm * 256 + wr * 64 + fr;
#pragma unroll
        for (int ai = 0; ai < 2; ++ai)
#pragma unroll
            for (int m = 0; m < 4; ++m) { const int row = row0 + ai * 128 + m * 16; const float rs = row_rstd(ssq, row);
#pragma unroll
                for (int bj = 0; bj < 2; ++bj) *(u4*)(O + (size_t)row * ldc + u.pn * 256 + bj * 128 + cl) = pack8(acc[ai][bj][m][0] * rs, acc[ai][bj][m][1] * rs); }
    }
};
struct EpiGateUp {
    static constexpr bool PERM = true, AFTER_DRAIN = false;
    bf16* O; const float* ssq;
    __device__ __forceinline__ void operator()(const f4 (&acc)[2][2][4][2], const pg8::Unit& u, int wr, int wc, int fr, int fq) const {
        const int cl = wc * 32 + 8 * fq, row0 = u.pm * 256 + wr * 64 + fr;
#pragma unroll
        for (int ai = 0; ai < 2; ++ai)
#pragma unroll
            for (int m = 0; m < 4; ++m) { const int row = row0 + ai * 128 + m * 16; const float rs = row_rstd(ssq, row);
                f4 o0, o1;
#pragma unroll
                for (int e = 0; e < 4; ++e) { const float g0 = acc[ai][0][m][0][e] * rs, g1 = acc[ai][0][m][1][e] * rs;
                    o0[e] = g0 * sigmoidf_(g0) * (acc[ai][1][m][0][e] * rs); o1[e] = g1 * sigmoidf_(g1) * (acc[ai][1][m][1][e] * rs); }
                *(u4*)(O + (size_t)row * DFF + u.pn * 128 + cl) = pack8(o0, o1); }
    }
};
struct DualOrder : pg8::StaticOrder {
    __device__ __forceinline__ bool next(int i, pg8::Unit& u) const { pg8::Unit t; if (!pg8::StaticOrder::next(i >> 1, t)) return false; const int w = i & 1; u.pm = t.pm + 64 * w; u.pn = t.pn + 8 * w; return true; }
};

struct Args { const float* in[19]; const int* pos; float* out; unsigned char* ws; };

#define GRID_BAR() xcd_barrier(bar)

__global__ void __launch_bounds__(NWAVES * 64, 2) hybrid_fwd(Args args) {
    extern __shared__ __attribute__((aligned(16))) unsigned char lds[];
    LAS unsigned char* L = (LAS unsigned char*)lds;
    volatile LAS unsigned* MISC = (volatile LAS unsigned*)(L + MISC_OFF);
    const int tid = threadIdx.x, lane = tid & 63, wave = __builtin_amdgcn_readfirstlane(tid >> 6);
    const int G = gridDim.x, bx = blockIdx.x;
    const int vcu = (G % 8 == 0) ? (bx % 8) * (G / 8) + bx / 8 : bx;
    unsigned char* ws = args.ws;
    gu32* ctl = (gu32*)(ws + WS_CTL);
    for (int u = tid; u < (LDS_BYTES - LDSCTL_OFF) / 4; u += NWAVES * 64) ((LAS unsigned*)(L + LDSCTL_OFF))[u] = 0u;
    __syncthreads();
    XcdBarrier bar = xcd_barrier_post((unsigned*)(ctl + CW_BAR), MISC + 8);
    const int gw = vcu * NWAVES + wave, NGW = G * NWAVES;

    const float* x = args.in[0]; const float* mem = args.in[1];
    const float* g_mix = args.in[2]; const float* w_in = args.in[3]; const float* w_up_ret = args.in[4]; const float* w_up_swa = args.in[5];
    const float* sinks = args.in[6]; const float* w_o = args.in[7]; const float* g_x = args.in[8]; const float* g_mem = args.in[9];
    const float* w_xq = args.in[10]; const float* w_xkv = args.in[11]; const float* w_xo = args.in[12]; const float* g_ffn = args.in[13];
    const float* w_gate = args.in[14]; const float* w_up = args.in[15]; const float* w_down = args.in[16]; const float* g_final = args.in[17];
    float* out = args.out;
    bf16* n1 = (bf16*)out;
    bf16* ST = (bf16*)out;

    {
        LAS float* scr = (LAS float*)(L + RING_OFF + wave * 16384);
        constexpr int I_IN = 32 * 304, I_UR = 16 * 64, I_US = 16 * 64, I_O = 32 * 64, I_XQ = 32 * 16, I_XKV = 32 * 32, I_XO = 8 * 64, I_G = 32 * 176, I_U = 32 * 176, I_DN = 88 * 64;
        constexpr int NITEMS = I_IN + I_UR + I_US + I_O + I_XQ + I_XKV + I_XO + I_G + I_U + I_DN;
        for (int it = gw; it < NITEMS; it += NGW) {
            int r = it;
            if (r < I_IN) { const int nblk = NIN / 32; p0_transpose_item(w_in, D, NIN, (bf16*)(ws + W_IN), r / nblk, r % nblk, 32 * (r % nblk), nullptr, scr, lane); continue; } r -= I_IN;
            if (r < I_UR) { const int nblk = 64; p0_transpose_item(w_up_ret, 1024, D, (bf16*)(ws + W_UR), r / nblk, r % nblk, 32 * (r % nblk), nullptr, scr, lane); continue; } r -= I_UR;
            if (r < I_US) { const int nblk = 64; p0_transpose_item(w_up_swa, 1024, D, (bf16*)(ws + W_US), r / nblk, r % nblk, 32 * (r % nblk), nullptr, scr, lane); continue; } r -= I_US;
            if (r < I_O) { const int nblk = 64; p0_transpose_item(w_o, D, D, (bf16*)(ws + W_O), r / nblk, r % nblk, 32 * (r % nblk), nullptr, scr, lane); continue; } r -= I_O;
            if (r < I_XQ) { const int nblk = 16; p0_transpose_item(w_xq, D, 512, (bf16*)(ws + W_XQ), r / nblk, r % nblk, 32 * (r % nblk), g_x, scr, lane); continue; } r -= I_XQ;
            if (r < I_XKV) { const int nblk = 32; p0_transpose_item(w_xkv, D, 1024, (bf16*)(ws + W_XKV), r / nblk, r % nblk, 32 * (r % nblk), nullptr, scr, lane); continue; } r -= I_XKV;
            if (r < I_XO) { const int nblk = 64; p0_transpose_item(w_xo, 512, D, (bf16*)(ws + W_XO), r / nblk, r % nblk, 32 * (r % nblk), nullptr, scr, lane); continue; } r -= I_XO;
            if (r < I_G) { const int nblk = 176, nb = r % nblk, n0 = 32 * nb; p0_transpose_item(w_gate, D, DFF, (bf16*)(ws + W_GU), r / nblk, nb, (n0 >> 7) * 256 + (n0 & 127), g_ffn, scr, lane); continue; } r -= I_G;
            if (r < I_U) { const int nblk = 176, nb = r % nblk, n0 = 32 * nb; p0_transpose_item(w_up, D, DFF, (bf16*)(ws + W_GU), r / nblk, nb, (n0 >> 7) * 256 + 128 + (n0 & 127), g_ffn, scr, lane); continue; } r -= I_U;
            { const int nblk = 64; p0_transpose_item(w_down, DFF, D, (bf16*)(ws + W_DN), r / nblk, r % nblk, 32 * (r % nblk), nullptr, scr, lane); }
        }
        for (int m = gw; m < M; m += NGW) rms_row_to_bf16(x + (size_t)m * D, g_mix, n1 + (size_t)m * D, lane);
        for (int m = gw; m < NMEM; m += NGW) rms_row_to_bf16(mem + (size_t)m * D, g_mem, (bf16*)(ws + WS_MEMN) + (size_t)m * D, lane);
        const int gt = vcu * (NWAVES * 64) + tid, NGT = G * NWAVES * 64;
        float* cosr = (float*)(ws + WS_COSR); float* sinr = (float*)(ws + WS_SINR); float* coss = (float*)(ws + WS_COSS); float* sins = (float*)(ws + WS_SINS);
        for (int idx = gt; idx < M * 136; idx += NGT) {
            const int t = idx / 136, i = idx % 136;
            const float posf = (float)args.pos[t];
            float inv;
            if (i < 128) inv = (float)exp2(-(double)i * (13.287712379549449 / 128.0));
            else inv = (float)exp2(-(double)(i - 128) * (18.931568569324174 / 8.0));
            const float ang = posf * inv;
            double rev = (double)ang * 0.15915494309189535; rev -= rint(rev);
            const float fr_ = (float)rev;
            const float c = __builtin_amdgcn_cosf(fr_), s = __builtin_amdgcn_sinf(fr_);
            if (i < 128) { cosr[(size_t)t * 128 + i] = c; sinr[(size_t)t * 128 + i] = s; } else { coss[(size_t)t * 8 + (i - 128)] = c; sins[(size_t)t * 8 + (i - 128)] = s; }
        }
    }
    GRID_BAR();

    {
        pg8::Gemm g{n1, (const bf16*)(ws + W_IN), M, NIN, D}; pg8::StaticOrder S; S.init(M, NIN, G, bx);
        EpiInProj E{ws};
        pg8::gemm_phase<EpiInProj, pg8::StaticOrder, PG8_ALIGN, PG8_SP2>(L + RING_OFF, g, S, E);
        pg8::Gemm g2{(const bf16*)(ws + WS_MEMN), (const bf16*)(ws + W_XKV), NMEM, 1024, D}; pg8::StaticOrder S2; S2.init(NMEM, 1024, G, G - 1 - bx);
        EpiPlain E2{(bf16*)(ws + WS_KVM), 1024};
        pg8::gemm_phase<EpiPlain, pg8::StaticOrder, PG8_ALIGN, PG8_SP2>(L + RING_OFF, g2, S2, E2);
    }
    GRID_BAR();

    {
        const bf16* KD = (const bf16*)(ws + A_KD); const bf16* VR = (const bf16*)(ws + A_VR);
        const int gt = vcu * (NWAVES * 64) + tid;
        for (int el = gt; el < 4 * 256 * 128; el += G * NWAVES * 64) {
            const int h = el >> 15, d = (el >> 7) & 255, e0 = (el & 127) * 2;
            const float decay = exp2f(128.0f * log2_gamma(h));
            float s0 = 0.f, s1 = 0.f;
            for (int n = 0; n < 128; ++n) {
                *(unsigned*)(ST + (((size_t)(h * 128 + n) * 256 + d) * 256 + e0)) = pk2(s0, s1);
                if (n == 127) break;
                float a0 = 0.f, a1 = 0.f;
                const bf16* kp = KD + (size_t)(n * 128) * 1024 + h * 256 + d; const bf16* vp = VR + (size_t)(n * 128) * 1024 + h * 256 + e0;
#pragma unroll 8
                for (int j = 0; j < 128; ++j) { const float kd = bf2f(kp[(size_t)j * 1024]); const unsigned vv = *(const unsigned*)(vp + (size_t)j * 1024); a0 += kd * bflo(vv); a1 += kd * bfhi(vv); }
                s0 = s0 * decay + a0; s1 = s1 * decay + a1;
            }
        }
    }
    {
        bf16* QS = (bf16*)(ws + A_QS); const bf16* KS = (const bf16*)(ws + A_KS); const bf16* VS = (const bf16*)(ws + A_VS);
        for (int un = gw; un < M * 16; un += NGW) {
            const int i = un >> 4, hq = un & 15, kvh = hq >> 2;
            const bf16* qp = QS + (size_t)i * 1024 + hq * 64;
            const int t1 = i - lane, t2 = i - 64 - lane;
            const bf16* k1 = KS + (size_t)(t1 < 0 ? 0 : t1) * 256 + kvh * 64; const bf16* k2 = KS + (size_t)(t2 < 0 ? 0 : t2) * 256 + kvh * 64;
            float s1 = 0.f, s2 = 0.f;
#pragma unroll
            for (int c = 0; c < 8; ++c) { const u4 q = *(const u4*)(qp + 8 * c), a = *(const u4*)(k1 + 8 * c), b = *(const u4*)(k2 + 8 * c);
                s1 += bflo(q.x) * bflo(a.x) + bfhi(q.x) * bfhi(a.x) + bflo(q.y) * bflo(a.y) + bfhi(q.y) * bfhi(a.y) + bflo(q.z) * bflo(a.z) + bfhi(q.z) * bfhi(a.z) + bflo(q.w) * bflo(a.w) + bfhi(q.w) * bfhi(a.w);
                s2 += bflo(q.x) * bflo(b.x) + bfhi(q.x) * bfhi(b.x) + bflo(q.y) * bflo(b.y) + bfhi(q.y) * bfhi(b.y) + bflo(q.z) * bflo(b.z) + bfhi(q.z) * bfhi(b.z) + bflo(q.w) * bflo(b.w) + bfhi(q.w) * bfhi(b.w); }
            if (t1 < 0) s1 = -1e30f; if (t2 < 0) s2 = -1e30f;
            const float sink = sinks[hq];
            const float mx = fmaxf(wave_max(fmaxf(s1, s2)), sink);
            const float p1 = t1 < 0 ? 0.f : __expf(s1 - mx), p2 = t2 < 0 ? 0.f : __expf(s2 - mx);
            const float den = wave_sum(p1 + p2) + __expf(sink - mx);
            float o = 0.f;
            const bf16* vb = VS + kvh * 64 + lane;
            for (int l = 0; l < 64; ++l) { const int t = i - l; if (t < 0) break; o += __shfl(p1, l) * bf2f(vb[(size_t)t * 256]); }
            for (int l = 0; l < 64; ++l) { const int t = i - 64 - l; if (t < 0) break; o += __shfl(p2, l) * bf2f(vb[(size_t)t * 256]); }
            asm volatile("s_waitcnt vmcnt(0)" ::: "memory");
            ((bf16*)qp)[lane] = (bf16)f2bf(o / den);
        }
    }
    GRID_BAR();
    {
        bf16* QR = (bf16*)(ws + A_QR); const bf16* KR = (const bf16*)(ws + A_KR); const bf16* VR = (const bf16*)(ws + A_VR); const bf16* GR = (const bf16*)(ws + A_GR);
        LAS float* Psh = (LAS float*)(L + RING_OFF); LAS float* qsh = Psh + 128; LAS float* osh = qsh + 256; LAS float* red = osh + 512;
        for (int un = vcu; un < M * 4; un += G) {
            const int i = un >> 2, h = un & 3, n = i >> 7, li = i & 127, t0 = n << 7;
            const float l2g = log2_gamma(h);
            const bf16* qp = QR + (size_t)i * 1024 + h * 256;
            {
                const int j = tid >> 2, part = tid & 3;
                const bf16* kp = KR + (size_t)(t0 + j) * 1024 + h * 256 + part * 64; const bf16* qq = qp + part * 64;
                float s = 0.f;
#pragma unroll
                for (int c = 0; c < 8; ++c) { const u4 q = *(const u4*)(qq + 8 * c), a = *(const u4*)(kp + 8 * c);
                    s += bflo(q.x) * bflo(a.x) + bfhi(q.x) * bfhi(a.x) + bflo(q.y) * bflo(a.y) + bfhi(q.y) * bfhi(a.y) + bflo(q.z) * bflo(a.z) + bfhi(q.z) * bfhi(a.z) + bflo(q.w) * bflo(a.w) + bfhi(q.w) * bfhi(a.w); }
                s += __shfl_xor(s, 1); s += __shfl_xor(s, 2);
                if (part == 0) Psh[j] = (j <= li) ? s * exp2f((float)(li - j) * l2g) : 0.f;
                if (tid < 256) qsh[tid] = bf2f(qp[tid]);
            }
            __syncthreads();
            {
                const int e = tid & 255;
                float o = 0.f;
                if (tid < 256) { const bf16* vp = VR + (size_t)t0 * 1024 + h * 256 + e;
                    for (int j = 0; j <= li; ++j) o += Psh[j] * bf2f(vp[(size_t)j * 1024]); }
                else { const bf16* sp = ST + ((size_t)(h * 128 + n) * 256) * 256 + e;
#pragma unroll 8
                    for (int d = 0; d < 256; ++d) o += qsh[d] * bf2f(sp[(size_t)d * 256]);
                    o *= exp2f((float)(li + 1) * l2g); }
                osh[tid] = o;
            }
            __syncthreads();
            float o = 0.f;
            if (tid < 256) { o = osh[tid] + osh[tid + 256]; const float ss = wave_sum(o * o); if (lane == 0) red[wave] = ss; }
            __syncthreads();
            if (tid < 256) { const float ss = (red[0] + red[1]) + (red[2] + red[3]);
                const float y = o * (1.0f / sqrtf(ss * (1.f / 256.f) + EPS)) * bf2f(GR[(size_t)i * 1024 + h * 256 + tid]);
                ((bf16*)qp)[tid] = (bf16)f2bf(y); }
            __syncthreads();
        }
    }
    GRID_BAR();

    {
        pg8::Gemm g{(const bf16*)(ws + A_QR), (const bf16*)(ws + W_UR), 2 * M, 2 * D, 1024}; DualOrder S; S.init(M, D, G, bx);
        EpiUp E{ws};
        pg8::gemm_phase<EpiUp, DualOrder, PG8_ALIGN, PG8_SP2>(L + RING_OFF, g, S, E);
    }
    GRID_BAR();
    {
        pg8::Gemm g{(const bf16*)(ws + A_MERGED), (const bf16*)(ws + W_O), M, D, D}; pg8::StaticOrder S; S.init(M, D, G, bx);
        EpiResid E{x, out, (bf16*)(ws + A_H1B), (float*)(ws + WS_SSQ1)};
        pg8::gemm_phase<EpiResid, pg8::StaticOrder, PG8_ALIGN, PG8_SP2>(L + RING_OFF, g, S, E);
    }
    GRID_BAR();
    {
        pg8::Gemm g{(const bf16*)(ws + A_H1B), (const bf16*)(ws + W_XQ), M, 512, D}; pg8::StaticOrder S; S.init(M, 512, G, bx);
        EpiRstd E{(bf16*)(ws + A_XQ), 512, (const float*)(ws + WS_SSQ1)};
        pg8::gemm_phase<EpiRstd, pg8::StaticOrder, PG8_ALIGN, PG8_SP2>(L + RING_OFF, g, S, E);
    }
    GRID_BAR();
    {
        const bf16* XQ = (const bf16*)(ws + A_XQ); const bf16* KVM = (const bf16*)(ws + WS_KVM); bf16* XA = (bf16*)(ws + A_XA);
        for (int un = gw; un < M * 4; un += NGW) {
            const int i = un >> 2, hx = un & 3;
            const bf16* qp = XQ + (size_t)i * 512 + hx * 128;
            float s[4] = {0.f, 0.f, 0.f, 0.f};
#pragma unroll
            for (int c = 0; c < 16; ++c) { const u4 q = *(const u4*)(qp + 8 * c);
#pragma unroll
                for (int r = 0; r < 4; ++r) { const u4 a = *(const u4*)(KVM + (size_t)(lane + 64 * r) * 1024 + hx * 128 + 8 * c);
                    s[r] += bflo(q.x) * bflo(a.x) + bfhi(q.x) * bfhi(a.x) + bflo(q.y) * bflo(a.y) + bfhi(q.y) * bfhi(a.y) + bflo(q.z) * bflo(a.z) + bfhi(q.z) * bfhi(a.z) + bflo(q.w) * bflo(a.w) + bfhi(q.w) * bfhi(a.w); } }
            const float sc = 0.08838834764831845f;
#pragma unroll
            for (int r = 0; r < 4; ++r) s[r] *= sc;
            const float mx = wave_max(fmaxf(fmaxf(s[0], s[1]), fmaxf(s[2], s[3])));
            float p[4];
#pragma unroll
            for (int r = 0; r < 4; ++r) p[r] = __expf(s[r] - mx);
            const float den = wave_sum((p[0] + p[1]) + (p[2] + p[3]));
            float o0 = 0.f, o1 = 0.f;
            const bf16* vb = KVM + 512 + hx * 128 + lane;
#pragma unroll
            for (int r = 0; r < 4; ++r)
                for (int l = 0; l < 64; ++l) { const float pp = __shfl(p[r], l); const bf16* vv = vb + (size_t)(l + 64 * r) * 1024; o0 += pp * bf2f(vv[0]); o1 += pp * bf2f(vv[64]); }
            const float rd = 1.0f / den;
            XA[(size_t)i * 512 + hx * 128 + lane] = (bf16)f2bf(o0 * rd); XA[(size_t)i * 512 + hx * 128 + 64 + lane] = (bf16)f2bf(o1 * rd);
        }
    }
    GRID_BAR();
    {
        pg8::Gemm g{(const bf16*)(ws + A_XA), (const bf16*)(ws + W_XO), M, D, 512}; pg8::StaticOrder S; S.init(M, D, G, bx);
        EpiResid E{out, out, (bf16*)(ws + A_H2B), (float*)(ws + WS_SSQ2)};
        pg8::gemm_phase<EpiResid, pg8::StaticOrder, PG8_ALIGN, PG8_SP2>(L + RING_OFF, g, S, E);
    }
    GRID_BAR();
    {
        pg8::Gemm g{(const bf16*)(ws + A_H2B), (const bf16*)(ws + W_GU), M, 2 * DFF, D}; pg8::StaticOrder S; S.init(M, 2 * DFF, G, bx);
        EpiGateUp E{(bf16*)(ws + A_ACTF), (const float*)(ws + WS_SSQ2)};
        pg8::gemm_phase<EpiGateUp, pg8::StaticOrder, PG8_ALIGN, PG8_SP2>(L + RING_OFF, g, S, E);
    }
    GRID_BAR();
    {
        pg8::Gemm g{(const bf16*)(ws + A_ACTF), (const bf16*)(ws + W_DN), M, D, DFF}; pg8::StaticOrder S; S.init(M, D, G, bx);
        EpiResid E{out, out, nullptr, (float*)(ws + WS_SSQ3)};
        pg8::gemm_phase<EpiResid, pg8::StaticOrder, PG8_ALIGN, PG8_SP2>(L + RING_OFF, g, S, E);
    }
    GRID_BAR();
    {
        const float* ssq = (const float*)(ws + WS_SSQ3);
        for (int m = gw; m < M; m += NGW) {
            const float rs = row_rstd(ssq, m);
            GAS f4* xr = (GAS f4*)(out + (size_t)m * D) + lane; const GAS f4* gr = (const GAS f4*)g_final + lane;
#pragma unroll
            for (int j = 0; j < 8; ++j) { const f4 v = xr[64 * j], gg = gr[64 * j]; xr[64 * j] = v * rs * gg; }
        }
    }
}

extern "C" void kernel_launch(void* const* d_in, const int* in_sizes, int n_in, void* d_out, int out_size, void* d_ws, size_t ws_size, hipStream_t stream) {
    static int grid = 0;
    if (grid == 0) {
        if (n_in != 19 || in_sizes[0] != M * D || out_size != M * D || ws_size < WS_END) { fprintf(stderr, "kernel_launch: unexpected shapes (n_in %d, in0 %d, out %d, ws %zu); nothing launched\n", n_in, n_in > 0 ? in_sizes[0] : -1, out_size, ws_size); grid = -1; return; }
        int dev = 0, cus = 0, per_cu = 0;
        if (hipGetDevice(&dev) != hipSuccess || hipDeviceGetAttribute(&cus, hipDeviceAttributeMultiprocessorCount, dev) != hipSuccess) { grid = -1; return; }
        if (hipFuncSetAttribute((const void*)hybrid_fwd, hipFuncAttributeMaxDynamicSharedMemorySize, LDS_BYTES) != hipSuccess) { fprintf(stderr, "kernel_launch: hipFuncSetAttribute failed\n"); grid = -1; return; }
        if (hipOccupancyMaxActiveBlocksPerMultiprocessor(&per_cu, (const void*)hybrid_fwd, NWAVES * 64, LDS_BYTES) != hipSuccess || per_cu < 1)
            fprintf(stderr, "kernel_launch: note: occupancy query reports %d workgroups per CU\n", per_cu);
        (void)hipGetLastError();
        grid = cus;
    }
    if (grid < 0) return;
    if (hipMemsetAsync((char*)d_ws + WS_CTL, 0, CTL_ZERO_BYTES, stream) != hipSuccess) { fprintf(stderr, "kernel_launch: hipMemsetAsync failed\n"); return; }
    Args a{};
    a.in[0] = (const float*)d_in[0]; a.in[1] = (const float*)d_in[1]; a.pos = (const int*)d_in[2];
    for (int i = 3; i < 19; ++i) a.in[i - 1] = (const float*)d_in[i];
    a.in[18] = nullptr;
    a.out = (float*)d_out; a.ws = (unsigned char*)d_ws;
    hipLaunchKernelGGL(hybrid_fwd, dim3(grid), dim3(NWAVES * 64), LDS_BYTES, stream, a);
    const hipError_t le = hipPeekAtLastError();
    if (le != hipSuccess) fprintf(stderr, "kernel_launch: launch failed: %s\n", hipGetErrorName(le));
}
```

```cpp
#include <hip/hip_runtime.h>
#include <cstdio>
#include <cstdint>
namespace pg8 {
#define PG8_LAS __attribute__((address_space(3)))
typedef unsigned short bf16_t;
typedef short bf16x8 __attribute__((ext_vector_type(8)));
typedef float f32x4 __attribute__((ext_vector_type(4)));
typedef unsigned u32x4 __attribute__((ext_vector_type(4)));
constexpr int BM = 256, BK = 64, HALF = 128, HTB = HALF * BK * 2  , STAGE_BYTES = 8 * HTB, NXCD = 8, WGM = 8;

__host__ __device__ __forceinline__ int lds_byte(int r, int c) { const int st = (r >> 4) * 2 + (c >> 5), rr = r & 15, cc = c & 31, ob = rr * 64 + cc * 2; return st * 1024 + (ob ^ (((ob >> 9) & 1) << 5)); }
__host__ __device__ __forceinline__ void stage_rc(int b, int& R, int& C) { const int st = b / 1024, sb = b % 1024, swz = sb ^ (((sb >> 9) & 1) << 5); R = (st >> 1) * 16 + swz / 64; C = (st & 1) * 32 + (swz % 64) / 2; }
__host__ __device__ __forceinline__ int perm32(int rho) { const int n = rho >> 4, i = rho & 15; return 8 * (i >> 2) + 4 * n + (i & 3); }

struct Unit { int pm, pn; };
struct Gemm { const bf16_t* A; const bf16_t* Bt; int M, N, K; };

struct StaticOrder {
    int nM, nN, nwg, G, c;
    __host__ __device__ void init(int M, int N, int G_, int c_) { nM = M / BM; nN = N / BM; nwg = nM * nN; G = G_; c = c_; }
    __host__ __device__ bool next(int i, Unit& u) const {
        const long L = (long)i * G + c; if (L >= nwg) return false;
        int wgid = (int)L; { const int q = nwg / NXCD, r = nwg % NXCD, xcd = wgid % NXCD, off = wgid / NXCD; wgid = (xcd < r ? xcd * (q + 1) : r * (q + 1) + (xcd - r) * q) + off; }
        const int nig = WGM * nN, gid = wgid / nig, fm = gid * WGM, gsz = (nM - fm) < WGM ? (nM - fm) : WGM;
        u.pm = fm + ((wgid % nig) % gsz); u.pn = (wgid % nig) / gsz; return true;
    }
    __device__ __forceinline__ void a_ready(const Unit&) const {}
    __device__ __forceinline__ void done(const Unit&) const {}
};

__device__ __forceinline__ unsigned cvt_pk_bf16(float lo, float hi) { unsigned r; asm volatile("v_cvt_pk_bf16_f32 %0, %1, %2" : "=v"(r) : "v"(lo), "v"(hi)); return r; }
typedef float f32x2 __attribute__((ext_vector_type(2)));
template <class Epi, class Sched, bool ALIGN_EPI = false, bool SP2 = false>
__device__ __forceinline__ void gemm_phase(PG8_LAS unsigned char* lds, const Gemm g, const Sched& S, const Epi& E) {
    int tid_ = threadIdx.x; asm volatile("" : "+v"(tid_));
    const int tid = tid_, wid = __builtin_amdgcn_readfirstlane(tid >> 6), lane = tid & 63, wr = wid >> 2, wc = wid & 3, fr = lane & 15, fq = lane >> 4;
    const int K = g.K, nt = K / BK;
    unsigned voffA[2], voffB[2];
#pragma unroll
    for (int i = 0; i < 2; ++i) { int R, C; stage_rc(tid * 16 + i * 8192, R, C); const int Rb = Epi::PERM ? ((R & ~31) + perm32(R & 31)) : R;
        voffA[i] = (unsigned)(R * K + C) * 2u; voffB[i] = (unsigned)(Rb * K + C) * 2u; }
    const size_t kstep = (size_t)(BK * 2);
    const size_t hstep = (size_t)HALF * K * 2;
    const size_t tstep = 2 * hstep;
    const unsigned ldsw = (unsigned)wid * 1024u;
    const int aoff = lds_byte(wr * 64 + fr, fq * 8), boff = lds_byte(wc * 32 + fr, fq * 8);
#define PG8_SA(b, h) (((b) * 2 + (h)) * HTB)
#define PG8_SB(b, h) ((4 + (b) * 2 + (h)) * HTB)
#define PG8_STAGE(bufoff, gbase, voff) do { _Pragma("unroll") for (int _i = 0; _i < 2; ++_i) \
        __builtin_amdgcn_global_load_lds((const unsigned*)((const char*)(gbase) + (voff)[_i]), (PG8_LAS unsigned*)(lds + (bufoff) + ldsw + _i * 8192), 16, 0, 0); } while (0)
#define PG8_LDA(dst, b, h) do { _Pragma("unroll") for (int m = 0; m < 4; ++m) _Pragma("unroll") for (int k = 0; k < 2; ++k) dst[m][k] = *(const PG8_LAS bf16x8*)(lds + PG8_SA(b, h) + aoff + m * 2048 + k * 1024); } while (0)
#define PG8_LDB(dst, b, h) do { _Pragma("unroll") for (int n = 0; n < 2; ++n) _Pragma("unroll") for (int k = 0; k < 2; ++k) dst[n][k] = *(const PG8_LAS bf16x8*)(lds + PG8_SB(b, h) + boff + n * 2048 + k * 1024); } while (0)
#define PG8_MMA(ai, bj, At, Bt) do { __builtin_amdgcn_s_setprio(1); _Pragma("unroll") for (int m = 0; m < 4; ++m) _Pragma("unroll") for (int n = 0; n < 2; ++n) _Pragma("unroll") for (int k = 0; k < 2; ++k) \
        acc[ai][bj][m][n] = __builtin_amdgcn_mfma_f32_16x16x32_bf16(Bt[n][k], At[m][k], acc[ai][bj][m][n], 0, 0, 0); __builtin_amdgcn_s_setprio(0); } while (0)
#define PG8_WAIT_V(n) asm volatile("s_waitcnt vmcnt(" #n ")" ::: "memory")
#define PG8_WAIT_L(n) asm volatile("s_waitcnt lgkmcnt(" #n ")" ::: "memory")
#define PG8_BAR __builtin_amdgcn_s_barrier()
#define PG8_SCHED __builtin_amdgcn_sched_barrier(0)
    Unit cur, nxt; int ui = 0;
    if (!S.next(0, cur)) return;
    f32x4 acc[2][2][4][2];
#pragma unroll
    for (int a = 0; a < 2; ++a)
#pragma unroll
        for (int b = 0; b < 2; ++b)
#pragma unroll
            for (int m = 0; m < 4; ++m)
#pragma unroll
                for (int n = 0; n < 2; ++n) acc[a][b][m][n] = (f32x4){0.f, 0.f, 0.f, 0.f};
    bf16x8 At[4][2], B0[2][2], B1[2][2];
    const char* cA = (const char*)g.A + (size_t)cur.pm * tstep; const char* cB = (const char*)g.Bt + (size_t)cur.pn * tstep;
    S.a_ready(cur);
    if constexpr (SP2) {
        PG8_STAGE(PG8_SB(0, 0), cB, voffB); PG8_STAGE(PG8_SB(0, 1), cB + hstep, voffB); PG8_STAGE(PG8_SA(0, 0), cA, voffA); PG8_STAGE(PG8_SA(0, 1), cA + hstep, voffA);
        if (wr == 1) PG8_BAR;
        PG8_WAIT_V(2); PG8_BAR;
        PG8_STAGE(PG8_SB(1, 0), cB + kstep, voffB); PG8_STAGE(PG8_SA(1, 0), cA + kstep, voffA); PG8_STAGE(PG8_SB(1, 1), cB + hstep + kstep, voffB);
        PG8_WAIT_V(6); PG8_BAR;
    } else {
        PG8_STAGE(PG8_SB(0, 0), cB, voffB); PG8_STAGE(PG8_SA(0, 0), cA, voffA); PG8_STAGE(PG8_SB(0, 1), cB + hstep, voffB); PG8_STAGE(PG8_SA(0, 1), cA + hstep, voffA);
        if (wr == 1) PG8_BAR;
        PG8_WAIT_V(4); PG8_BAR;
        PG8_STAGE(PG8_SB(1, 0), cB + kstep, voffB); PG8_STAGE(PG8_SA(1, 0), cA + kstep, voffA); PG8_STAGE(PG8_SB(1, 1), cB + hstep + kstep, voffB);
        PG8_WAIT_V(6); PG8_BAR;
    }
    for (;;) {
        const bool has_next = S.next(ui + 1, nxt);
        const char* nA = has_next ? (const char*)g.A + (size_t)nxt.pm * tstep : cA; const char* nB = has_next ? (const char*)g.Bt + (size_t)nxt.pn * tstep : cB;
        for (int t = 0; t < nt; t += 2) {
            const bool last = (t == nt - 2);
            const char* a1 = cA + (size_t)(t + 1) * kstep;
            const char* a2 = last ? nA : cA + (size_t)(t + 2) * kstep; const char* b2 = last ? nB : cB + (size_t)(t + 2) * kstep;
            const char* a3 = a2 + kstep; const char* b3 = b2 + kstep;
            if (last && has_next) S.a_ready(nxt);
            if constexpr (SP2) {
            PG8_LDB(B0, 0, 0); PG8_LDB(B1, 0, 1); PG8_SCHED; PG8_LDA(At, 0, 0); PG8_STAGE(PG8_SA(1, 1), a1 + hstep, voffA);
            PG8_WAIT_V(8); PG8_WAIT_L(0); PG8_BAR; PG8_MMA(0, 0, At, B0); PG8_MMA(0, 1, At, B1); PG8_BAR; PG8_SCHED;
            PG8_LDA(At, 0, 1); PG8_STAGE(PG8_SB(0, 0), b2, voffB); PG8_STAGE(PG8_SB(0, 1), b2 + hstep, voffB); PG8_STAGE(PG8_SA(0, 0), a2, voffA);
            PG8_WAIT_V(8); PG8_WAIT_L(0); PG8_BAR; PG8_MMA(1, 0, At, B0); PG8_MMA(1, 1, At, B1); PG8_BAR; PG8_SCHED;
            PG8_LDB(B0, 1, 0); PG8_LDB(B1, 1, 1); PG8_SCHED; PG8_LDA(At, 1, 0); PG8_STAGE(PG8_SA(0, 1), a2 + hstep, voffA);
            PG8_WAIT_V(8); PG8_WAIT_L(0); PG8_BAR; PG8_MMA(0, 0, At, B0); PG8_MMA(0, 1, At, B1); PG8_BAR; PG8_SCHED;
            PG8_LDA(At, 1, 1); PG8_STAGE(PG8_SB(1, 0), b3, voffB); PG8_STAGE(PG8_SB(1, 1), b3 + hstep, voffB); PG8_STAGE(PG8_SA(1, 0), a3, voffA);
            PG8_WAIT_V(8); PG8_WAIT_L(0); PG8_BAR; PG8_MMA(1, 0, At, B0); PG8_MMA(1, 1, At, B1); PG8_BAR; PG8_SCHED;
            } else {
            PG8_LDB(B0, 0, 0); PG8_SCHED; PG8_LDA(At, 0, 0); PG8_STAGE(PG8_SA(1, 1), a1 + hstep, voffA);
            PG8_WAIT_L(8); PG8_BAR; PG8_WAIT_L(0); PG8_MMA(0, 0, At, B0); PG8_BAR; PG8_SCHED;
            PG8_LDB(B1, 0, 1); PG8_STAGE(PG8_SB(0, 0), b2, voffB);
            PG8_BAR; PG8_WAIT_L(0); PG8_MMA(0, 1, At, B1); PG8_BAR;
            PG8_LDA(At, 0, 1); PG8_STAGE(PG8_SA(0, 0), a2, voffA);
            PG8_BAR; PG8_WAIT_L(0); PG8_MMA(1, 0, At, B0); PG8_BAR; PG8_SCHED;
            PG8_STAGE(PG8_SB(0, 1), b2 + hstep, voffB);
            PG8_WAIT_V(6); PG8_BAR; PG8_MMA(1, 1, At, B1); PG8_BAR;
            PG8_LDB(B0, 1, 0); PG8_SCHED; PG8_LDA(At, 1, 0); PG8_STAGE(PG8_SA(0, 1), a2 + hstep, voffA);
            PG8_WAIT_L(8); PG8_BAR; PG8_WAIT_L(0); PG8_MMA(0, 0, At, B0); PG8_BAR; PG8_SCHED;
            PG8_LDB(B1, 1, 1); PG8_STAGE(PG8_SB(1, 0), b3, voffB);
            PG8_BAR; PG8_WAIT_L(0); PG8_MMA(0, 1, At, B1); PG8_BAR;
            PG8_LDA(At, 1, 1); PG8_STAGE(PG8_SA(1, 0), a3, voffA);
            PG8_BAR; PG8_WAIT_L(0); PG8_MMA(1, 0, At, B0); PG8_BAR; PG8_SCHED;
            PG8_STAGE(PG8_SB(1, 1), b3 + hstep, voffB);
            PG8_WAIT_V(6); PG8_BAR; PG8_MMA(1, 1, At, B1); PG8_BAR;
            }
        }
        if constexpr (ALIGN_EPI) { if (wr == 0) PG8_BAR; }
        if constexpr (!Epi::AFTER_DRAIN) { E(acc, cur, wr, wc, fr, fq); S.done(cur); }
        if (!has_next) break;
#pragma unroll
        for (int a = 0; a < 2; ++a)
#pragma unroll
            for (int b = 0; b < 2; ++b)
#pragma unroll
                for (int m = 0; m < 4; ++m)
#pragma unroll
                    for (int n = 0; n < 2; ++n) acc[a][b][m][n] = (f32x4){0.f, 0.f, 0.f, 0.f};
        cur = nxt; cA = nA; cB = nB; ++ui;
        if constexpr (ALIGN_EPI) { if (wr == 1) PG8_BAR; }
    }
    PG8_WAIT_V(0);
    if constexpr (!ALIGN_EPI) { if (wr == 0) PG8_BAR; }
    PG8_BAR;
    if constexpr (Epi::AFTER_DRAIN) { E.fused(acc, cur, wr, wc, fr, fq, lds, wid, lane); S.done(cur); }
#undef PG8_SA
#undef PG8_SB
#undef PG8_STAGE
#undef PG8_LDA
#undef PG8_LDB
#undef PG8_MMA
#undef PG8_WAIT_V
#undef PG8_WAIT_L
#undef PG8_BAR
#undef PG8_SCHED
}
}

#ifndef PG8_SP2
#define PG8_SP2 true
#endif
#ifndef PG8_ALIGN
#define PG8_ALIGN true
#endif
#define GAS __attribute__((address_space(1)))
#define LAS __attribute__((address_space(3)))
typedef unsigned short bf16;
typedef unsigned v4u __attribute__((ext_vector_type(4)));
typedef float f32x4 __attribute__((ext_vector_type(4)));
typedef short bf16x8 __attribute__((ext_vector_type(8)));
typedef GAS unsigned gu32;
typedef GAS unsigned long long gu64;
#define RLX_AGENT __ATOMIC_RELAXED, __HIP_MEMORY_SCOPE_AGENT
#define LDS_WAIT() asm volatile("s_waitcnt lgkmcnt(0)" ::: "memory")
#define VM_WAIT() asm volatile("s_waitcnt vmcnt(0)" ::: "memory")
__device__ __forceinline__ unsigned long long rt() { return __builtin_amdgcn_s_memrealtime(); }
__device__ __forceinline__ unsigned f2bf(float f) { unsigned u = __builtin_bit_cast(unsigned, f); return (u + 0x7fffu + ((u >> 16) & 1u)) >> 16; }
__device__ __forceinline__ unsigned pk2(float lo, float hi) { return f2bf(lo) | (f2bf(hi) << 16); }

#define XB_TMO      128
#define XB_XCNT(j)  (256  + 64 * (j))
#define XB_XSUB(j)  (1280 + 64 * (j))
#define XB_XGEN(j)  (2304 + 64 * (j))
#define XB_TOP      3328
#define XB_TOPGEN   3392
#define XCD_BAR_WORDS 3456
#define XB_SPIN_CAP (1u << 22)

__device__ __forceinline__ unsigned xb_ld(unsigned* p)              { return __hip_atomic_load(p, __ATOMIC_RELAXED, __HIP_MEMORY_SCOPE_AGENT); }
__device__ __forceinline__ unsigned xb_add(unsigned* p, unsigned v) { return __hip_atomic_fetch_add(p, v, __ATOMIC_RELAXED, __HIP_MEMORY_SCOPE_AGENT); }
__device__ __forceinline__ unsigned xb_xcc_id() { return (unsigned)__builtin_amdgcn_s_getreg((3 << 11) | 20) & 0xFu; }
#define XB_SPIN(cond, bar) do { unsigned _sp = 0; while (cond) { __builtin_amdgcn_s_sleep(1); \
    if ((++_sp & 255u) == 0u) { if (xb_ld(&(bar)[XB_TMO])) break; if (_sp > XB_SPIN_CAP) { atomicAdd(&(bar)[XB_TMO], 1u); break; } } } } while (0)

struct XcdBarrier {
    unsigned* bar; unsigned x;
    volatile LAS unsigned* st;
};

__device__ __forceinline__ XcdBarrier xcd_barrier_post(unsigned* bar, volatile LAS unsigned* st) {
    XcdBarrier b; b.bar = bar; b.x = xb_xcc_id(); b.st = st;
    if (threadIdx.x == 0) (void)xb_add(&bar[XB_XCNT(b.x)], 1u);
    return b;
}
__device__ __forceinline__ void xcd_barrier_complete(unsigned* bar, unsigned x, unsigned& nloc, unsigned& nx) {
    const unsigned G = gridDim.x * gridDim.y * gridDim.z;
    unsigned sum, cnt, mine, sp = 0u;
    for (;;) {
        sum = 0u; cnt = 0u; mine = 0u;
#pragma unroll
        for (unsigned j = 0; j < 16; ++j) { const unsigned c = xb_ld(&bar[XB_XCNT(j)]); sum += c; cnt += (c > 0u) ? 1u : 0u; mine = (j == x) ? c : mine; }
        if (sum == G) break;
        __builtin_amdgcn_s_sleep(1);
        if ((++sp & 255u) == 0u) { if (xb_ld(&bar[XB_TMO])) break; if (sp > XB_SPIN_CAP) { atomicAdd(&bar[XB_TMO], 1u); break; } }
    }
    nloc = mine > 0u ? mine : 1u; nx = cnt > 0u ? cnt : 1u;
}

__device__ __forceinline__ void xcd_barrier(const XcdBarrier& b) {
    asm volatile("s_waitcnt vmcnt(0)" ::: "memory");
    __syncthreads();
    if (threadIdx.x == 0) {
        unsigned* bar = b.bar;
        __builtin_amdgcn_s_waitcnt(0);
        unsigned nloc = b.st[0], nx = b.st[1];
        if (nloc == 0u) { xcd_barrier_complete(bar, b.x, nloc, nx); b.st[0] = nloc; b.st[1] = nx; }
        const unsigned old = xb_add(&bar[XB_XSUB(b.x)], 1u);
        const unsigned gen = old / nloc;
        if (old + 1u == (gen + 1u) * nloc) {
            __builtin_amdgcn_fence(__ATOMIC_RELEASE, "agent");
            asm volatile("s_waitcnt vmcnt(0)" ::: "memory");
            const unsigned og = xb_add(&bar[XB_TOP], 1u);
            const unsigned tg = og / nx;
            if (og + 1u == (tg + 1u) * nx) xb_add(&bar[XB_TOPGEN], 1u);
            else XB_SPIN(xb_ld(&bar[XB_TOPGEN]) == tg, bar);
            __builtin_amdgcn_fence(__ATOMIC_ACQUIRE, "agent");
            xb_add(&bar[XB_XGEN(b.x)], 1u);
            asm volatile("s_waitcnt vmcnt(0)" ::: "memory");
        } else {
            XB_SPIN(xb_ld(&bar[XB_XGEN(b.x)]) == gen, bar);
            __builtin_amdgcn_fence(__ATOMIC_ACQUIRE, "agent");
            asm volatile("s_waitcnt vmcnt(0)" ::: "memory");
        }
    }
    __syncthreads();
}

namespace mm {
typedef short bf16x8 __attribute__((ext_vector_type(8)));
typedef short s16x4 __attribute__((ext_vector_type(4)));
typedef float f32x16 __attribute__((ext_vector_type(16)));
typedef unsigned u32x4 __attribute__((ext_vector_type(4)));
#define MM_LAS __attribute__((address_space(3)))
#define MFMA32(a, b, c) __builtin_amdgcn_mfma_f32_32x32x16_bf16((a), (b), (c), 0, 0, 0)
__device__ __forceinline__ int crow(int i, int h) { return (i & 3) + 8 * (i >> 2) + 4 * h; }
template <int ROWB, int PITCH, int NROWS> __device__ __forceinline__ void stage_tile(MM_LAS unsigned char* dst, const unsigned short* src, long ld, int tid, int zero_below = 0) {
    constexpr int CPR = ROWB / 16, TOT = NROWS * CPR, PER = TOT / 512, B = PER > 8 ? 8 : PER;
    static_assert(TOT % 512 == 0 && PER % B == 0 && PITCH % 16 == 0, "stage_tile shape");
#pragma unroll
    for (int b0 = 0; b0 < PER; b0 += B) {
        u32x4 v[B];
#pragma unroll
        for (int c = 0; c < B; ++c) { const int id = tid + 512 * (b0 + c), row = id / CPR, ch = id % CPR;
            const int rl = row < zero_below ? zero_below : row;
            v[c] = *(const u32x4*)(src + (long)rl * ld + ch * 8);
            if (row < zero_below) v[c] = (u32x4){0u, 0u, 0u, 0u}; }
#pragma unroll
        for (int c = 0; c < B; ++c) { const int id = tid + 512 * (b0 + c), row = id / CPR, ch = id % CPR;
            *(MM_LAS u32x4*)(dst + row * PITCH + 16 * ch) = v[c]; }
    }
}
template <int PITCH> __device__ __forceinline__ bf16x8 frag_row(const MM_LAS unsigned char* t, int row, int kchunk) { return *(const MM_LAS bf16x8*)(t + row * PITCH + 16 * kchunk); }
__device__ __forceinline__ s16x4 vtr(const MM_LAS unsigned char* p) { typedef short v4i16_t __attribute__((ext_vector_type(4))); return __builtin_bit_cast(s16x4, __builtin_amdgcn_ds_read_tr16_b64_v4i16((MM_LAS v4i16_t*)p)); }
template <int PITCH, bool PERM> __device__ __forceinline__ int tr_lane(int lane) {
    const int g1 = (lane >> 4) & 1, h = lane >> 5, q = (lane >> 2) & 3, p = lane & 3;
    return ((PERM ? 4 * h : 8 * h) + q) * PITCH + 2 * (16 * g1 + 4 * p);
}
template <int PITCH, bool PERM> __device__ __forceinline__ bf16x8 frag_tr(const MM_LAS unsigned char* t, int trl, int kbase, int nbase) {
    const MM_LAS unsigned char* p = t + trl + kbase * PITCH + 2 * nbase;
    const s16x4 lo = vtr(p), hi = vtr(p + (PERM ? 8 : 4) * PITCH);
    return (bf16x8){lo[0], lo[1], lo[2], lo[3], hi[0], hi[1], hi[2], hi[3]};
}
__device__ __forceinline__ unsigned cvtpk(float lo, float hi) { typedef float f2_t __attribute__((ext_vector_type(2))); typedef __bf16 b2_t __attribute__((ext_vector_type(2))); f2_t v = {lo, hi}; b2_t b = __builtin_convertvector(v, b2_t); return __builtin_bit_cast(unsigned, b); }
__device__ __forceinline__ bf16x8 pack_step(const f32x16& x, int s) {
    u32x4 p; p.x = cvtpk(x[8 * s], x[8 * s + 1]); p.y = cvtpk(x[8 * s + 2], x[8 * s + 3]); p.z = cvtpk(x[8 * s + 4], x[8 * s + 5]); p.w = cvtpk(x[8 * s + 6], x[8 * s + 7]);
    return __builtin_bit_cast(bf16x8, p);
}
__device__ __forceinline__ unsigned short f2bf_(float f) { return (unsigned short)(cvtpk(f, 0.f) & 0xffffu); }
}

constexpr int NWAVES = 8;
constexpr int M = 16384, D = 2048, NIN = 9728, DFF = 5632, NMEM = 256;
constexpr float EPS = 1e-6f;
constexpr size_t MiB = 1u << 20;
constexpr size_t WS_CTL = 0, CTL_ZERO_BYTES = 1 * MiB;
constexpr size_t WS_SSQ1 = 1 * MiB, WS_SSQ2 = 3 * MiB, WS_SSQ3 = 5 * MiB;
constexpr size_t WS_MEMN = 7 * MiB;
constexpr size_t WS_KVM = 8 * MiB;
constexpr size_t WS_COSS = 9 * MiB, WS_SINS = 9 * MiB + 512 * 1024;
constexpr size_t WS_COSR = 10 * MiB, WS_SINR = 18 * MiB;
constexpr size_t WS_W = 26 * MiB;
constexpr size_t W_IN = WS_W, W_UR = WS_W + 38 * MiB, W_US = WS_W + 42 * MiB, W_O = WS_W + 46 * MiB, W_XQ = WS_W + 54 * MiB,
                 W_XKV = WS_W + 56 * MiB, W_XO = WS_W + 60 * MiB, W_GU = WS_W + 62 * MiB, W_DN = WS_W + 106 * MiB;
constexpr size_t WS_ACT = 154 * MiB;
constexpr size_t A_QR = WS_ACT + 0 * MiB, A_QS = WS_ACT + 32 * MiB, A_KR = WS_ACT + 64 * MiB, A_KD = WS_ACT + 96 * MiB, A_VR = WS_ACT + 128 * MiB,
                 A_GR = WS_ACT + 160 * MiB, A_KS = WS_ACT + 192 * MiB, A_VS = WS_ACT + 200 * MiB, A_SGR = WS_ACT + 208 * MiB, A_SGS = WS_ACT + 272 * MiB;
constexpr size_t A_MERGED = WS_ACT + 64 * MiB, A_H1B = WS_ACT + 128 * MiB, A_XQ = WS_ACT + 0 * MiB, A_XA = WS_ACT + 16 * MiB, A_H2B = WS_ACT + 64 * MiB,
                 A_ACTF = WS_ACT + 160 * MiB;
constexpr size_t WS_END = 490 * MiB;
static_assert(A_ACTF + (size_t)M * DFF * 2 <= WS_END && WS_END <= 512 * MiB, "d_ws map");
constexpr int CW_BAR = 4096;
constexpr int RING_OFF = 0, RING_BYTES = 131072;
constexpr int LDSCTL_OFF = 155648, MISC_OFF = LDSCTL_OFF + 320;
constexpr int LDS_BYTES = 163840;

typedef pg8::f32x4 f4;
typedef unsigned u4 __attribute__((ext_vector_type(4)));
typedef unsigned u2 __attribute__((ext_vector_type(2)));
__device__ __forceinline__ float bf2f(unsigned short b) { return __uint_as_float((unsigned)b << 16); }
__device__ __forceinline__ float bflo(unsigned w) { return __uint_as_float(w << 16); }
__device__ __forceinline__ float bfhi(unsigned w) { return __uint_as_float(w & 0xffff0000u); }
__device__ __forceinline__ float wave_sum(float v) {
#pragma unroll
    for (int o = 1; o < 64; o <<= 1) v += __shfl_xor(v, o);
    return v;
}
__device__ __forceinline__ float wave_max(float v) {
#pragma unroll
    for (int o = 1; o < 64; o <<= 1) v = fmaxf(v, __shfl_xor(v, o));
    return v;
}
__device__ __forceinline__ float sigmoidf_(float v) { return 1.0f / (1.0f + __expf(-v)); }
__device__ __forceinline__ u4 pack8(const f4& a, const f4& b) {
    u4 w; w.x = pg8::cvt_pk_bf16(a[0], a[1]); w.y = pg8::cvt_pk_bf16(a[2], a[3]); w.z = pg8::cvt_pk_bf16(b[0], b[1]); w.w = pg8::cvt_pk_bf16(b[2], b[3]); return w;
}
__device__ __forceinline__ float log2_gamma(int h) {
    return h == 0 ? -0.045803689613124704f : h == 1 ? -0.022720076500083645f : h == 2 ? -0.011315313227834157f : -0.005646563141142062f;
}

__device__ __forceinline__ void p0_transpose_item(const float* W, int K, int N, bf16* WT, int kb, int nb, int drow0, const float* gk, LAS float* scr, int lane) {
    const int k0 = 64 * kb, n0 = 32 * nb;
#pragma unroll 8
    for (int i = 0; i < 32; ++i) { const int kk = 2 * i + (lane >> 5); float w = W[(size_t)(k0 + kk) * N + n0 + (lane & 31)]; if (gk) w *= gk[k0 + kk]; scr[kk * 33 + (lane & 31)] = w; }
    LDS_WAIT(); asm volatile("" ::: "memory");
    const int c = lane & 7;
#pragma unroll
    for (int j = 0; j < 4; ++j) { const int n = (lane >> 3) + 8 * j; const LAS float* s = scr + (8 * c) * 33 + n;
        v4u o; o.x = pk2(s[0 * 33], s[1 * 33]); o.y = pk2(s[2 * 33], s[3 * 33]); o.z = pk2(s[4 * 33], s[5 * 33]); o.w = pk2(s[6 * 33], s[7 * 33]);
        *(GAS v4u*)(WT + (size_t)(drow0 + n) * K + k0 + 8 * c) = o; }
    LDS_WAIT(); asm volatile("" ::: "memory");
}
__device__ __forceinline__ void rms_row_to_bf16(const float* xrow, const float* g, bf16* orow, int lane) {
    const GAS f4* xr = (const GAS f4*)xrow + lane; const GAS f4* gr = (const GAS f4*)g + lane;
    f4 v[8]; float s = 0.f;
#pragma unroll
    for (int j = 0; j < 8; ++j) { v[j] = xr[64 * j]; s += (v[j].x * v[j].x + v[j].y * v[j].y) + (v[j].z * v[j].z + v[j].w * v[j].w); }
    const float rstd = 1.0f / sqrtf(wave_sum(s) * (1.f / 2048.f) + EPS);
    GAS unsigned long long* o8 = (GAS unsigned long long*)orow + lane;
#pragma unroll
    for (int j = 0; j < 8; ++j) { const f4 gg = gr[64 * j]; o8[64 * j] = (unsigned long long)pk2(v[j].x * rstd * gg.x, v[j].y * rstd * gg.y) | ((unsigned long long)pk2(v[j].z * rstd * gg.z, v[j].w * rstd * gg.w) << 32); }
}

struct EpiInProj {
    static constexpr bool PERM = true, AFTER_DRAIN = false;
    unsigned char* ws;
    __device__ __forceinline__ void operator()(const f4 (&acc)[2][2][4][2], const pg8::Unit& u, int wr, int wc, int fr, int fq) const {
        const int pn = u.pn, cl = wc * 32 + 8 * fq, row0 = u.pm * 256 + wr * 64 + fr;
        const float* cosr = (const float*)(ws + WS_COSR); const float* sinr = (const float*)(ws + WS_SINR);
        const float* coss = (const float*)(ws + WS_COSS); const float* sins = (const float*)(ws + WS_SINS);
        if (pn < 8) {
            const bool isk = pn >= 4; const int hh = pn & 3;
            bf16* dst = (bf16*)(ws + (isk ? A_KR : A_QR)); bf16* dkd = (bf16*)(ws + A_KD);
            const float l2g = log2_gamma(hh);
#pragma unroll
            for (int ai = 0; ai < 2; ++ai)
#pragma unroll
                for (int m = 0; m < 4; ++m) { const int row = row0 + ai * 128 + m * 16;
                    const f4 c0 = *(const f4*)(cosr + (size_t)row * 128 + cl), c1 = *(const f4*)(cosr + (size_t)row * 128 + cl + 4);
                    const f4 s0 = *(const f4*)(sinr + (size_t)row * 128 + cl), s1 = *(const f4*)(sinr + (size_t)row * 128 + cl + 4);
                    const f4 a0 = acc[ai][0][m][0], a1 = acc[ai][0][m][1], b0 = acc[ai][1][m][0], b1 = acc[ai][1][m][1];
                    f4 y0 = a0 * c0 - b0 * s0, y1 = a1 * c1 - b1 * s1, z0 = b0 * c0 + a0 * s0, z1 = b1 * c1 + a1 * s1;
                    if (isk) { y0 = y0 * 0.0625f; y1 = y1 * 0.0625f; z0 = z0 * 0.0625f; z1 = z1 * 0.0625f; }
                    bf16* p = dst + (size_t)row * 1024 + hh * 256 + cl;
                    *(u4*)p = pack8(y0, y1); *(u4*)(p + 128) = pack8(z0, z1);
                    if (isk) { const float dec = exp2f((float)(127 - (row & 127)) * l2g);
                        bf16* q = dkd + (size_t)row * 1024 + hh * 256 + cl;
                        *(u4*)q = pack8(y0 * dec, y1 * dec); *(u4*)(q + 128) = pack8(z0 * dec, z1 * dec); } }
        } else if (pn < 16 || pn >= 21) {
            bf16* dst; int ld, colb, mode;
            if (pn < 12) { dst = (bf16*)(ws + A_VR); ld = 1024; colb = (pn - 8) * 256; mode = 0; }
            else if (pn < 16) { dst = (bf16*)(ws + A_GR); ld = 1024; colb = (pn - 12) * 256; mode = 1; }
            else if (pn == 21) { dst = (bf16*)(ws + A_VS); ld = 256; colb = 0; mode = 0; }
            else if (pn < 30) { dst = (bf16*)(ws + A_SGR); ld = 2048; colb = (pn - 22) * 256; mode = 2; }
            else { dst = (bf16*)(ws + A_SGS); ld = 2048; colb = (pn - 30) * 256; mode = 2; }
#pragma unroll
            for (int ai = 0; ai < 2; ++ai)
#pragma unroll
                for (int m = 0; m < 4; ++m) { const int row = row0 + ai * 128 + m * 16;
#pragma unroll
                    for (int bj = 0; bj < 2; ++bj) { f4 v0 = acc[ai][bj][m][0], v1 = acc[ai][bj][m][1];
                        if (mode != 0) {
#pragma unroll
                            for (int e = 0; e < 4; ++e) { const float g0 = sigmoidf_(v0[e]), g1 = sigmoidf_(v1[e]); v0[e] = mode == 1 ? v0[e] * g0 : g0; v1[e] = mode == 1 ? v1[e] * g1 : g1; } }
                        *(u4*)(dst + (size_t)row * ld + colb + bj * 128 + cl) = pack8(v0, v1); } }
        } else {
            const bool isq = pn < 20;
            bf16* dst = (bf16*)(ws + (isq ? A_QS : A_KS)); const int ld = isq ? 1024 : 256, colb = isq ? (pn - 16) * 256 : 0;
            const int hc = cl & 63;
            const float sc = isq ? 0.125f * 1.4426950408889634f : 1.0f;
            const float fc = (hc < 16) ? 1.f : 0.f, fs = (hc == 0) ? -1.f : (hc == 8) ? 1.f : 0.f;
#pragma unroll
            for (int ai = 0; ai < 2; ++ai)
#pragma unroll
                for (int m = 0; m < 4; ++m) { const int row = row0 + ai * 128 + m * 16;
                    const f4 c0 = *(const f4*)(coss + (size_t)row * 8), c1 = *(const f4*)(coss + (size_t)row * 8 + 4);
                    const f4 s0 = *(const f4*)(sins + (size_t)row * 8), s1 = *(const f4*)(sins + (size_t)row * 8 + 4);
#pragma unroll
                    for (int bj = 0; bj < 2; ++bj) { f4 v0 = acc[ai][bj][m][0], v1 = acc[ai][bj][m][1]; f4 p0, p1;
#pragma unroll
                        for (int e = 0; e < 4; ++e) { p0[e] = __shfl_xor(v0[e], 16); p1[e] = __shfl_xor(v1[e], 16); }
                        v0 = v0 * ((c0 - 1.f) * fc + 1.f) + p0 * (s0 * fs); v1 = v1 * ((c1 - 1.f) * fc + 1.f) + p1 * (s1 * fs);
                        v0 = v0 * sc; v1 = v1 * sc;
                        *(u4*)(dst + (size_t)row * ld + colb + bj * 128 + cl) = pack8(v0, v1); } }
        }
    }
};
struct EpiPlain {
    static constexpr bool PERM = true, AFTER_DRAIN = false;
    bf16* O; int ldc;
    __device__ __forceinline__ void operator()(const f4 (&acc)[2][2][4][2], const pg8::Unit& u, int wr, int wc, int fr, int fq) const {
        const int cl = wc * 32 + 8 * fq, row0 = u.pm * 256 + wr * 64 + fr;
#pragma unroll
        for (int ai = 0; ai < 2; ++ai)
#pragma unroll
            for (int m = 0; m < 4; ++m) { const int row = row0 + ai * 128 + m * 16;
#pragma unroll
                for (int bj = 0; bj < 2; ++bj) *(u4*)(O + (size_t)row * ldc + u.pn * 256 + bj * 128 + cl) = pack8(acc[ai][bj][m][0], acc[ai][bj][m][1]); }
    }
};
struct EpiUp {
    static constexpr bool PERM = true, AFTER_DRAIN = false;
    unsigned char* ws;
    __device__ __forceinline__ void operator()(const f4 (&acc)[2][2][4][2], const pg8::Unit& u, int wr, int wc, int fr, int fq) const {
        const int w = u.pm >= 64 ? 1 : 0, pm = u.pm & 63, pn = u.pn & 7;
        const int cl = wc * 32 + 8 * fq, row0 = pm * 256 + wr * 64 + fr;
        const bf16* gate = (const bf16*)(ws + (w ? A_SGS : A_SGR)); bf16* mg = (bf16*)(ws + A_MERGED);
#pragma unroll
        for (int ai = 0; ai < 2; ++ai)
#pragma unroll
            for (int m = 0; m < 4; ++m) { const int row = row0 + ai * 128 + m * 16;
#pragma unroll
                for (int bj = 0; bj < 2; ++bj) { const size_t off = (size_t)row * 2048 + pn * 256 + bj * 128 + cl;
                    const u4 g = *(const u4*)(gate + off); f4 v0 = acc[ai][bj][m][0], v1 = acc[ai][bj][m][1];
                    v0[0] *= bflo(g.x); v0[1] *= bfhi(g.x); v0[2] *= bflo(g.y); v0[3] *= bfhi(g.y); v1[0] *= bflo(g.z); v1[1] *= bfhi(g.z); v1[2] *= bflo(g.w); v1[3] *= bfhi(g.w);
                    if (w) { const u4 p = *(const u4*)(mg + off);
                        v0[0] += bflo(p.x); v0[1] += bfhi(p.x); v0[2] += bflo(p.y); v0[3] += bfhi(p.y); v1[0] += bflo(p.z); v1[1] += bfhi(p.z); v1[2] += bflo(p.w); v1[3] += bfhi(p.w); }
                    *(u4*)(mg + off) = pack8(v0, v1); } }
    }
};
struct EpiResid {
    static constexpr bool PERM = true, AFTER_DRAIN = false;
    const float* base; float* out; bf16* hb; float* ssq;
    __device__ __forceinline__ void operator()(const f4 (&acc)[2][2][4][2], const pg8::Unit& u, int wr, int wc, int fr, int fq) const {
        const int cl = wc * 32 + 8 * fq, row0 = u.pm * 256 + wr * 64 + fr;
#pragma unroll
        for (int ai = 0; ai < 2; ++ai)
#pragma unroll
            for (int m = 0; m < 4; ++m) { const int row = row0 + ai * 128 + m * 16; float ss = 0.f;
#pragma unroll
                for (int bj = 0; bj < 2; ++bj) { const size_t off = (size_t)row * 2048 + u.pn * 256 + bj * 128 + cl;
                    const f4 x0 = *(const f4*)(base + off), x1 = *(const f4*)(base + off + 4);
                    const f4 h0 = x0 + acc[ai][bj][m][0], h1 = x1 + acc[ai][bj][m][1];
                    *(f4*)(out + off) = h0; *(f4*)(out + off + 4) = h1;
                    if (hb) *(u4*)(hb + off) = pack8(h0, h1);
                    ss += (h0[0] * h0[0] + h0[1] * h0[1]) + (h0[2] * h0[2] + h0[3] * h0[3]) + (h1[0] * h1[0] + h1[1] * h1[1]) + (h1[2] * h1[2] + h1[3] * h1[3]); }
                ss += __shfl_xor(ss, 16); ss += __shfl_xor(ss, 32);
                if (fq == 0) ssq[(size_t)row * 32 + u.pn * 4 + wc] = ss; }
    }
};
__device__ __forceinline__ float row_rstd(const float* ssq, int row) {
    const f4* p = (const f4*)(ssq + (size_t)row * 32); float s = 0.f;
#pragma unroll
    for (int i = 0; i < 8; ++i) { const f4 v = p[i]; s += (v[0] + v[1]) + (v[2] + v[3]); }
    return 1.0f / sqrtf(s * (1.f / 2048.f) + EPS);
}
struct EpiRstd {
    static constexpr bool PERM = true, AFTER_DRAIN = false;
    bf16* O; int ldc; const float* ssq; float scale;
    __device__ __forceinline__ void operator()(const f4 (&acc)[2][2][4][2], const pg8::Unit& u, int wr, int wc, int fr, int fq) const {
        const int cl = wc * 32 + 8 * fq, row0 = u.pm * 256 + wr * 64 + fr;
#pragma unroll
        for (int ai = 0; ai < 2; ++ai)
#pragma unroll
            for (int m = 0; m < 4; ++m) { const int row = row0 + ai * 128 + m * 16; const float rs = row_rstd(ssq, row) * scale;
#pragma unroll
                for (int bj = 0; bj < 2; ++bj) *(u4*)(O + (size_t)row * ldc + u.pn * 256 + bj * 128 + cl) = pack8(acc[ai][bj][m][0] * rs, acc[ai][bj][m][1] * rs); }
    }
};
struct EpiGateUp {
    static constexpr bool PERM = true, AFTER_DRAIN = false;
    bf16* O; const float* ssq;
    __device__ __forceinline__ void operator()(const f4 (&acc)[2][2][4][2], const pg8::Unit& u, int wr, int wc, int fr, int fq) const {
        const int cl = wc * 32 + 8 * fq, row0 = u.pm * 256 + wr * 64 + fr;
#pragma unroll
        for (int ai = 0; ai < 2; ++ai)
#pragma unroll
            for (int m = 0; m < 4; ++m) { const int row = row0 + ai * 128 + m * 16; const float rs = row_rstd(ssq, row);
                f4 o0, o1;
#pragma unroll
                for (int e = 0; e < 4; ++e) { const float g0 = acc[ai][0][m][0][e] * rs, g1 = acc[ai][0][m][1][e] * rs;
                    o0[e] = g0 * sigmoidf_(g0) * (acc[ai][1][m][0][e] * rs); o1[e] = g1 * sigmoidf_(g1) * (acc[ai][1][m][1][e] * rs); }
                *(u4*)(O + (size_t)row * DFF + u.pn * 128 + cl) = pack8(o0, o1); }
    }
};
struct DualOrder : pg8::StaticOrder {
    __device__ __forceinline__ bool next(int i, pg8::Unit& u) const { pg8::Unit t; if (!pg8::StaticOrder::next(i >> 1, t)) return false; const int w = i & 1; u.pm = t.pm + 64 * w; u.pn = t.pn + 8 * w; return true; }
};


constexpr int XTRA_OFF = LDSCTL_OFF + 1024;
static_assert(XTRA_OFF + 2048 <= LDS_BYTES, "XTRA scratch");
#define OPAQUE_TID() int tid_ = threadIdx.x; asm volatile("" : "+v"(tid_)); const int tid = tid_, lane = tid & 63, wave = __builtin_amdgcn_readfirstlane(tid >> 6), r32 = lane & 31, hi = lane >> 5

__device__ __forceinline__ void swa_phase(LAS unsigned char* L, unsigned char* ws, const float* sinks, int vcu, int G) {
    using namespace mm;
    bf16* QS = (bf16*)(ws + A_QS); const bf16* KS = (const bf16*)(ws + A_KS); const bf16* VS = (const bf16*)(ws + A_VS);
    constexpr int PK = 144, PV = 192;
    LAS unsigned char* Kt = L; LAS unsigned char* Vt = L + 256 * PK;
    for (int un = vcu; un < 512; un += G) {
        OPAQUE_TID();
        LAS float* ssh = (LAS float*)(L + XTRA_OFF) + wave * 32;
        const int trl = tr_lane<PV, true>(lane);
        const int kvh = un & 3, n = un >> 2;
        const long tok0 = (long)n * 128 - 128;
        stage_tile<128, PK, 256>(Kt, KS + tok0 * 256 + kvh * 64, 256, tid, n == 0 ? 128 : 0);
        stage_tile<128, PV, 256>(Vt, VS + tok0 * 256 + kvh * 64, 256, tid, n == 0 ? 128 : 0);
        __syncthreads();
        const int hq = kvh * 4 + (wave >> 1);
        const float sink2 = sinks[hq] * 1.4426950408889634f;
#pragma unroll 1
        for (int sb = 0; sb < 2; ++sb) {
            const int q0 = (wave & 1) * 64 + sb * 32;
            bf16* qrow = QS + ((long)n * 128 + q0 + r32) * 1024 + hq * 64;
            bf16x8 qf[4];
#pragma unroll
            for (int s = 0; s < 4; ++s) qf[s] = *(const bf16x8*)(qrow + 16 * s + 8 * hi);
            f32x16 st[5];
#pragma unroll
            for (int t5 = 0; t5 < 5; ++t5) { f32x16 a = {};
#pragma unroll
                for (int s = 0; s < 4; ++s) a = MFMA32(frag_row<PK>(Kt, q0 + 32 * t5 + r32, 2 * s + hi), qf[s], a);
                st[t5] = a; }
            float mx = sink2;
#pragma unroll
            for (int t5 = 0; t5 < 5; ++t5)
#pragma unroll
                for (int i = 0; i < 16; ++i) { const int kr = crow(i, hi); bool ok = true;
                    if (t5 == 0) ok = kr > r32;
                    if (t5 == 4) ok = kr <= r32;
                    if (n == 0 && q0 + 32 * t5 < 128) ok = false;
                    st[t5][i] = ok ? st[t5][i] : -INFINITY; mx = fmaxf(mx, st[t5][i]); }
            mx = fmaxf(mx, __shfl_xor(mx, 32));
            float sum = 0.f;
#pragma unroll
            for (int t5 = 0; t5 < 5; ++t5)
#pragma unroll
                for (int i = 0; i < 16; ++i) { const float p = __builtin_amdgcn_exp2f(st[t5][i] - mx); st[t5][i] = p; sum += p; }
            sum += __shfl_xor(sum, 32);
            sum += __builtin_amdgcn_exp2f(sink2 - mx);
            f32x16 o[2] = {{}, {}};
#pragma unroll
            for (int t5 = 0; t5 < 5; ++t5)
#pragma unroll
                for (int ks = 0; ks < 2; ++ks) { const bf16x8 pa = pack_step(st[t5], ks);
#pragma unroll
                    for (int db = 0; db < 2; ++db) o[db] = MFMA32(pa, (frag_tr<PV, true>(Vt, trl, q0 + 32 * t5 + 16 * ks, 32 * db)), o[db]); }
            if (hi == 0) ssh[r32] = 1.0f / sum;
            asm volatile("s_waitcnt lgkmcnt(0)" ::: "memory");
#pragma unroll
            for (int i = 0; i < 16; ++i) { const int qr = crow(i, hi); const float rl = ssh[qr];
                bf16* orow = QS + ((long)n * 128 + q0 + qr) * 1024 + hq * 64 + r32;
                orow[0] = f2bf_(o[0][i] * rl); orow[32] = f2bf_(o[1][i] * rl); }
            asm volatile("s_waitcnt lgkmcnt(0)" ::: "memory");
        }
        __syncthreads();
    }
}

__device__ __forceinline__ void xattn_phase(LAS unsigned char* L, unsigned char* ws, int vcu, int G) {
    using namespace mm;
    const bf16* XQ = (const bf16*)(ws + A_XQ); const bf16* KVM = (const bf16*)(ws + WS_KVM); bf16* XA = (bf16*)(ws + A_XA);
    constexpr int PK = 272, PV = 320;
    LAS unsigned char* Kt = L; LAS unsigned char* Vt = L + 256 * PK;
    for (int un = vcu; un < 256; un += G) {
        OPAQUE_TID();
        LAS float* ssh = (LAS float*)(L + XTRA_OFF) + wave * 32;
        const int trl = tr_lane<PV, true>(lane);
        const int hx = un & 3, tg = un >> 2;
        stage_tile<256, PK, 256>(Kt, KVM + hx * 128, 1024, tid);
        stage_tile<256, PV, 256>(Vt, KVM + 512 + hx * 128, 1024, tid);
        __syncthreads();
        const long tokb = (long)tg * 256 + wave * 32;
        const bf16* qrow = XQ + (tokb + r32) * 512 + hx * 128;
        bf16x8 qf[8];
#pragma unroll
        for (int s = 0; s < 8; ++s) qf[s] = *(const bf16x8*)(qrow + 16 * s + 8 * hi);
        f32x16 mt;
#pragma unroll
        for (int i = 0; i < 16; ++i) mt[i] = -INFINITY;
#pragma unroll 1
        for (int kt = 0; kt < 8; ++kt) { f32x16 a = {};
#pragma unroll
            for (int s = 0; s < 8; ++s) a = MFMA32(frag_row<PK>(Kt, 32 * kt + r32, 2 * s + hi), qf[s], a);
#pragma unroll
            for (int i = 0; i < 16; ++i) mt[i] = fmaxf(mt[i], a[i]); }
        float mx = mt[0];
#pragma unroll
        for (int i = 1; i < 16; ++i) mx = fmaxf(mx, mt[i]);
        mx = fmaxf(mx, __shfl_xor(mx, 32));
        f32x16 o[4] = {{}, {}, {}, {}}; float sum = 0.f;
#pragma unroll 1
        for (int kt = 0; kt < 8; ++kt) { f32x16 a = {};
#pragma unroll
            for (int s = 0; s < 8; ++s) a = MFMA32(frag_row<PK>(Kt, 32 * kt + r32, 2 * s + hi), qf[s], a);
#pragma unroll
            for (int i = 0; i < 16; ++i) { a[i] = __builtin_amdgcn_exp2f(a[i] - mx); sum += a[i]; }
#pragma unroll
            for (int ks = 0; ks < 2; ++ks) { const bf16x8 pa = pack_step(a, ks);
#pragma unroll
                for (int db = 0; db < 4; ++db) o[db] = MFMA32(pa, (frag_tr<PV, true>(Vt, trl, 32 * kt + 16 * ks, 32 * db)), o[db]); } }
        sum += __shfl_xor(sum, 32);
        if (hi == 0) ssh[r32] = 1.0f / sum;
        asm volatile("s_waitcnt lgkmcnt(0)" ::: "memory");
#pragma unroll
        for (int i = 0; i < 16; ++i) { const int qr = crow(i, hi); const float rl = ssh[qr];
            bf16* orow = XA + (tokb + qr) * 512 + hx * 128 + r32;
#pragma unroll
            for (int db = 0; db < 4; ++db) orow[32 * db] = f2bf_(o[db][i] * rl); }
        __syncthreads();
    }
}

__device__ __forceinline__ void ret_kv_phase(LAS unsigned char* L, unsigned char* ws, bf16* ST, int vcu, int G) {
    using namespace mm;
    const bf16* KD = (const bf16*)(ws + A_KD); const bf16* VR = (const bf16*)(ws + A_VR);
    constexpr int PT = 576;
    LAS unsigned char* Vt = L; LAS unsigned char* Kt = L + 128 * PT;
    for (int un = vcu; un < 512; un += G) {
        OPAQUE_TID();
        const int trl = tr_lane<PT, false>(lane);
        const int h = un & 3, n = un >> 2;
        stage_tile<512, PT, 128>(Vt, VR + (long)n * 128 * 1024 + h * 256, 1024, tid);
        stage_tile<512, PT, 128>(Kt, KD + (long)n * 128 * 1024 + h * 256, 1024, tid);
        __syncthreads();
        f32x16 acc[8] = {{}, {}, {}, {}, {}, {}, {}, {}};
#pragma unroll 2
        for (int s = 0; s < 8; ++s) { const bf16x8 a = frag_tr<PT, false>(Vt, trl, 16 * s, 32 * wave);
#pragma unroll
            for (int nb = 0; nb < 8; ++nb) acc[nb] = MFMA32(a, (frag_tr<PT, false>(Kt, trl, 16 * s, 32 * nb)), acc[nb]); }
        bf16* dst = ST + ((long)(h * 128 + n) * 256 + 32 * wave) * 256 + r32;
#pragma unroll
        for (int nb = 0; nb < 8; ++nb)
#pragma unroll
            for (int i = 0; i < 16; ++i) dst[(long)crow(i, hi) * 256 + 32 * nb] = f2bf_(acc[nb][i]);
        __syncthreads();
    }
}
__device__ __forceinline__ void ret_scan_phase(bf16* ST, int vcu, int G) {
    const int gt = vcu * (NWAVES * 64) + (int)threadIdx.x;
    for (int el = gt; el < 4 * 32768; el += G * NWAVES * 64) {
        const int h = el >> 15;
        const float decay = exp2f(128.0f * log2_gamma(h));
        unsigned* p = (unsigned*)ST + (long)h * 128 * 32768 + (el & 32767);
        float s0 = 0.f, s1 = 0.f;
#pragma unroll 1
        for (int n0 = 0; n0 < 128; n0 += 16) {
            unsigned kv[16];
#pragma unroll
            for (int j = 0; j < 16; ++j) kv[j] = p[(long)(n0 + j) * 32768];
#pragma unroll
            for (int j = 0; j < 16; ++j) { p[(long)(n0 + j) * 32768] = pk2(s0, s1); s0 = s0 * decay + bflo(kv[j]); s1 = s1 * decay + bfhi(kv[j]); }
        }
    }
}
__device__ __forceinline__ void ret_out_phase(LAS unsigned char* L, unsigned char* ws, const bf16* ST, int vcu, int G) {
    using namespace mm;
    bf16* QR = (bf16*)(ws + A_QR); const bf16* KR = (const bf16*)(ws + A_KR); const bf16* VR = (const bf16*)(ws + A_VR); const bf16* GR = (const bf16*)(ws + A_GR);
    constexpr int PK = 528, PV = 576;
    LAS unsigned char* Kt = L; LAS unsigned char* Vt = L + 128 * PK;
    LAS float* red = (LAS float*)(L + XTRA_OFF + 1024);
    for (int un = vcu; un < 512; un += G) {
        OPAQUE_TID();
        const int trl = tr_lane<PV, true>(lane);
        const int qt = wave >> 1, dh = wave & 1;
        const int h = un & 3, n = un >> 2;
        const float l2g = log2_gamma(h);
        const long t0 = (long)n * 128;
        bf16x8 qf[16];
        { const bf16* qrow = QR + (t0 + 32 * qt + r32) * 1024 + h * 256;
#pragma unroll
            for (int s = 0; s < 16; ++s) qf[s] = *(const bf16x8*)(qrow + 16 * s + 8 * hi); }
        f32x16 o[4] = {{}, {}, {}, {}};
        if (n > 0) {
            stage_tile<512, PK, 256>(L, ST + (long)(h * 128 + n) * 65536, 256, tid);
            __syncthreads();
#pragma unroll
            for (int db = 0; db < 4; ++db)
#pragma unroll
                for (int s = 0; s < 16; ++s) o[db] = MFMA32(qf[s], frag_row<PK>(L, 128 * dh + 32 * db + r32, 2 * s + hi), o[db]);
#pragma unroll
            for (int i = 0; i < 16; ++i) { const float sc = exp2f((float)(32 * qt + crow(i, hi) + 1) * l2g);
#pragma unroll
                for (int db = 0; db < 4; ++db) o[db][i] *= sc; }
            __syncthreads();
        }
        stage_tile<512, PK, 128>(Kt, KR + t0 * 1024 + h * 256, 1024, tid);
        stage_tile<512, PV, 128>(Vt, VR + t0 * 1024 + h * 256, 1024, tid);
        __syncthreads();
#pragma unroll 1
        for (int kt = 0; kt <= qt; ++kt) {
            f32x16 st = {};
#pragma unroll
            for (int s = 0; s < 16; ++s) st = MFMA32(frag_row<PK>(Kt, 32 * kt + r32, 2 * s + hi), qf[s], st);
            const int dq = 32 * (qt - kt) + r32;
#pragma unroll
            for (int i = 0; i < 16; ++i) { const int d = dq - crow(i, hi); st[i] = d >= 0 ? st[i] * exp2f((float)d * l2g) : 0.f; }
#pragma unroll
            for (int ks = 0; ks < 2; ++ks) { const bf16x8 pa = pack_step(st, ks);
#pragma unroll
                for (int db = 0; db < 4; ++db) o[db] = MFMA32(pa, (frag_tr<PV, true>(Vt, trl, 32 * kt + 16 * ks, 128 * dh + 32 * db)), o[db]); }
        }
        float ss[16];
#pragma unroll
        for (int i = 0; i < 16; ++i) { float v = 0.f;
#pragma unroll
            for (int db = 0; db < 4; ++db) v += o[db][i] * o[db][i];
            v += __shfl_xor(v, 1); v += __shfl_xor(v, 2); v += __shfl_xor(v, 4); v += __shfl_xor(v, 8); v += __shfl_xor(v, 16);
            ss[i] = v; }
        if (r32 == 0) {
#pragma unroll
            for (int i = 0; i < 16; ++i) red[wave * 32 + crow(i, hi)] = ss[i]; }
        __syncthreads();
#pragma unroll
        for (int i = 0; i < 16; ++i) { const int qr = crow(i, hi);
            const float tot = red[wave * 32 + qr] + red[(wave ^ 1) * 32 + qr];
            const float rs = 1.0f / sqrtf(tot * (1.f / 256.f) + EPS);
            const long off = (t0 + 32 * qt + qr) * 1024 + h * 256 + 128 * dh + r32;
#pragma unroll
            for (int db = 0; db < 4; ++db) QR[off + 32 * db] = f2bf_(o[db][i] * rs * bf2f(GR[off + 32 * db])); }
        __syncthreads();
    }
}
struct Args { const float* in[19]; const int* pos; float* out; unsigned char* ws; };

#define GRID_BAR() xcd_barrier(bar)

__global__ void __launch_bounds__(NWAVES * 64, 2) hybrid_fwd(Args args) {
    extern __shared__ __attribute__((aligned(16))) unsigned char lds[];
    LAS unsigned char* L = (LAS unsigned char*)lds;
    volatile LAS unsigned* MISC = (volatile LAS unsigned*)(L + MISC_OFF);
    const int tid = threadIdx.x, lane = tid & 63, wave = __builtin_amdgcn_readfirstlane(tid >> 6);
    const int G = gridDim.x, bx = blockIdx.x;
    const int vcu = (G % 8 == 0) ? (bx % 8) * (G / 8) + bx / 8 : bx;
    unsigned char* ws = args.ws;
    gu32* ctl = (gu32*)(ws + WS_CTL);
    for (int u = tid; u < (LDS_BYTES - LDSCTL_OFF) / 4; u += NWAVES * 64) ((LAS unsigned*)(L + LDSCTL_OFF))[u] = 0u;
    __syncthreads();
    XcdBarrier bar = xcd_barrier_post((unsigned*)(ctl + CW_BAR), MISC + 8);
    const int gw = vcu * NWAVES + wave, NGW = G * NWAVES;

    const float* x = args.in[0]; const float* mem = args.in[1];
    const float* g_mix = args.in[2]; const float* w_in = args.in[3]; const float* w_up_ret = args.in[4]; const float* w_up_swa = args.in[5];
    const float* sinks = args.in[6]; const float* w_o = args.in[7]; const float* g_x = args.in[8]; const float* g_mem = args.in[9];
    const float* w_xq = args.in[10]; const float* w_xkv = args.in[11]; const float* w_xo = args.in[12]; const float* g_ffn = args.in[13];
    const float* w_gate = args.in[14]; const float* w_up = args.in[15]; const float* w_down = args.in[16]; const float* g_final = args.in[17];
    float* out = args.out;
    bf16* n1 = (bf16*)out;
    bf16* ST = (bf16*)out;

    {
        LAS float* scr = (LAS float*)(L + RING_OFF + wave * 16384);
        constexpr int I_IN = 32 * 304, I_UR = 16 * 64, I_US = 16 * 64, I_O = 32 * 64, I_XQ = 32 * 16, I_XKV = 32 * 32, I_XO = 8 * 64, I_G = 32 * 176, I_U = 32 * 176, I_DN = 88 * 64;
        constexpr int NITEMS = I_IN + I_UR + I_US + I_O + I_XQ + I_XKV + I_XO + I_G + I_U + I_DN;
        for (int it = gw; it < NITEMS; it += NGW) {
            int r = it;
            if (r < I_IN) { const int nblk = NIN / 32; p0_transpose_item(w_in, D, NIN, (bf16*)(ws + W_IN), r / nblk, r % nblk, 32 * (r % nblk), nullptr, scr, lane); continue; } r -= I_IN;
            if (r < I_UR) { const int nblk = 64; p0_transpose_item(w_up_ret, 1024, D, (bf16*)(ws + W_UR), r / nblk, r % nblk, 32 * (r % nblk), nullptr, scr, lane); continue; } r -= I_UR;
            if (r < I_US) { const int nblk = 64; p0_transpose_item(w_up_swa, 1024, D, (bf16*)(ws + W_US), r / nblk, r % nblk, 32 * (r % nblk), nullptr, scr, lane); continue; } r -= I_US;
            if (r < I_O) { const int nblk = 64; p0_transpose_item(w_o, D, D, (bf16*)(ws + W_O), r / nblk, r % nblk, 32 * (r % nblk), nullptr, scr, lane); continue; } r -= I_O;
            if (r < I_XQ) { const int nblk = 16; p0_transpose_item(w_xq, D, 512, (bf16*)(ws + W_XQ), r / nblk, r % nblk, 32 * (r % nblk), g_x, scr, lane); continue; } r -= I_XQ;
            if (r < I_XKV) { const int nblk = 32; p0_transpose_item(w_xkv, D, 1024, (bf16*)(ws + W_XKV), r / nblk, r % nblk, 32 * (r % nblk), nullptr, scr, lane); continue; } r -= I_XKV;
            if (r < I_XO) { const int nblk = 64; p0_transpose_item(w_xo, 512, D, (bf16*)(ws + W_XO), r / nblk, r % nblk, 32 * (r % nblk), nullptr, scr, lane); continue; } r -= I_XO;
            if (r < I_G) { const int nblk = 176, nb = r % nblk, n0 = 32 * nb; p0_transpose_item(w_gate, D, DFF, (bf16*)(ws + W_GU), r / nblk, nb, (n0 >> 7) * 256 + (n0 & 127), g_ffn, scr, lane); continue; } r -= I_G;
            if (r < I_U) { const int nblk = 176, nb = r % nblk, n0 = 32 * nb; p0_transpose_item(w_up, D, DFF, (bf16*)(ws + W_GU), r / nblk, nb, (n0 >> 7) * 256 + 128 + (n0 & 127), g_ffn, scr, lane); continue; } r -= I_U;
            { const int nblk = 64; p0_transpose_item(w_down, DFF, D, (bf16*)(ws + W_DN), r / nblk, r % nblk, 32 * (r % nblk), nullptr, scr, lane); }
        }
        for (int m = gw; m < M; m += NGW) rms_row_to_bf16(x + (size_t)m * D, g_mix, n1 + (size_t)m * D, lane);
        for (int m = gw; m < NMEM; m += NGW) rms_row_to_bf16(mem + (size_t)m * D, g_mem, (bf16*)(ws + WS_MEMN) + (size_t)m * D, lane);
        const int gt = vcu * (NWAVES * 64) + tid, NGT = G * NWAVES * 64;
        float* cosr = (float*)(ws + WS_COSR); float* sinr = (float*)(ws + WS_SINR); float* coss = (float*)(ws + WS_COSS); float* sins = (float*)(ws + WS_SINS);
        for (int idx = gt; idx < M * 136; idx += NGT) {
            const int t = idx / 136, i = idx % 136;
            const float posf = (float)args.pos[t];
            float inv;
            if (i < 128) inv = (float)exp2(-(double)i * (13.287712379549449 / 128.0));
            else inv = (float)exp2(-(double)(i - 128) * (18.931568569324174 / 8.0));
            const float ang = posf * inv;
            double rev = (double)ang * 0.15915494309189535; rev -= rint(rev);
            const float fr_ = (float)rev;
            const float c = __builtin_amdgcn_cosf(fr_), s = __builtin_amdgcn_sinf(fr_);
            if (i < 128) { cosr[(size_t)t * 128 + i] = c; sinr[(size_t)t * 128 + i] = s; } else { coss[(size_t)t * 8 + (i - 128)] = c; sins[(size_t)t * 8 + (i - 128)] = s; }
        }
    }
    GRID_BAR();

    {
        pg8::Gemm g{n1, (const bf16*)(ws + W_IN), M, NIN, D}; pg8::StaticOrder S; S.init(M, NIN, G, bx);
        EpiInProj E{ws};
        pg8::gemm_phase<EpiInProj, pg8::StaticOrder, PG8_ALIGN, PG8_SP2>(L + RING_OFF, g, S, E);
        pg8::Gemm g2{(const bf16*)(ws + WS_MEMN), (const bf16*)(ws + W_XKV), NMEM, 1024, D}; pg8::StaticOrder S2; S2.init(NMEM, 1024, G, G - 1 - bx);
        EpiPlain E2{(bf16*)(ws + WS_KVM), 1024};
        pg8::gemm_phase<EpiPlain, pg8::StaticOrder, PG8_ALIGN, PG8_SP2>(L + RING_OFF, g2, S2, E2);
    }
    GRID_BAR();

    ret_kv_phase(L + RING_OFF, ws, ST, vcu, G);
    swa_phase(L + RING_OFF, ws, sinks, vcu, G);
    GRID_BAR();
    ret_scan_phase(ST, vcu, G);
    GRID_BAR();
    ret_out_phase(L + RING_OFF, ws, ST, vcu, G);
    GRID_BAR();

    {
        pg8::Gemm g{(const bf16*)(ws + A_QR), (const bf16*)(ws + W_UR), 2 * M, 2 * D, 1024}; DualOrder S; S.init(M, D, G, bx);
        EpiUp E{ws};
        pg8::gemm_phase<EpiUp, DualOrder, PG8_ALIGN, PG8_SP2>(L + RING_OFF, g, S, E);
    }
    GRID_BAR();
    {
        pg8::Gemm g{(const bf16*)(ws + A_MERGED), (const bf16*)(ws + W_O), M, D, D}; pg8::StaticOrder S; S.init(M, D, G, bx);
        EpiResid E{x, out, (bf16*)(ws + A_H1B), (float*)(ws + WS_SSQ1)};
        pg8::gemm_phase<EpiResid, pg8::StaticOrder, PG8_ALIGN, PG8_SP2>(L + RING_OFF, g, S, E);
    }
    GRID_BAR();
    {
        pg8::Gemm g{(const bf16*)(ws + A_H1B), (const bf16*)(ws + W_XQ), M, 512, D}; pg8::StaticOrder S; S.init(M, 512, G, bx);
        EpiRstd E{(bf16*)(ws + A_XQ), 512, (const float*)(ws + WS_SSQ1), 0.08838834764831845f * 1.4426950408889634f};
        pg8::gemm_phase<EpiRstd, pg8::StaticOrder, PG8_ALIGN, PG8_SP2>(L + RING_OFF, g, S, E);
    }
    GRID_BAR();
    xattn_phase(L + RING_OFF, ws, vcu, G);
    GRID_BAR();
    {
        pg8::Gemm g{(const bf16*)(ws + A_XA), (const bf16*)(ws + W_XO), M, D, 512}; pg8::StaticOrder S; S.init(M, D, G, bx);
        EpiResid E{out, out, (bf16*)(ws + A_H2B), (float*)(ws + WS_SSQ2)};
        pg8::gemm_phase<EpiResid, pg8::StaticOrder, PG8_ALIGN, PG8_SP2>(L + RING_OFF, g, S, E);
    }
    GRID_BAR();
    {
        pg8::Gemm g{(const bf16*)(ws + A_H2B), (const bf16*)(ws + W_GU), M, 2 * DFF, D}; pg8::StaticOrder S; S.init(M, 2 * DFF, G, bx);
        EpiGateUp E{(bf16*)(ws + A_ACTF), (const float*)(ws + WS_SSQ2)};
        pg8::gemm_phase<EpiGateUp, pg8::StaticOrder, PG8_ALIGN, PG8_SP2>(L + RING_OFF, g, S, E);
    }
    GRID_BAR();
    {
        pg8::Gemm g{(const bf16*)(ws + A_ACTF), (const bf16*)(ws + W_DN), M, D, DFF}; pg8::StaticOrder S; S.init(M, D, G, bx);
        EpiResid E{out, out, nullptr, (float*)(ws + WS_SSQ3)};
        pg8::gemm_phase<EpiResid, pg8::StaticOrder, PG8_ALIGN, PG8_SP2>(L + RING_OFF, g, S, E);
    }
    GRID_BAR();
    {
        const float* ssq = (const float*)(ws + WS_SSQ3);
        for (int m = gw; m < M; m += NGW) {
            const float rs = row_rstd(ssq, m);
            GAS f4* xr = (GAS f4*)(out + (size_t)m * D) + lane; const GAS f4* gr = (const GAS f4*)g_final + lane;
#pragma unroll
            for (int j = 0; j < 8; ++j) { const f4 v = xr[64 * j], gg = gr[64 * j]; xr[64 * j] = v * rs * gg; }
        }
    }
}

extern "C" void kernel_launch(void* const* d_in, const int* in_sizes, int n_in, void* d_out, int out_size, void* d_ws, size_t ws_size, hipStream_t stream) {
    static int grid = 0;
    if (grid == 0) {
        if (n_in != 19 || in_sizes[0] != M * D || out_size != M * D || ws_size < WS_END) { fprintf(stderr, "kernel_launch: unexpected shapes (n_in %d, in0 %d, out %d, ws %zu); nothing launched\n", n_in, n_in > 0 ? in_sizes[0] : -1, out_size, ws_size); grid = -1; return; }
        int dev = 0, cus = 0, per_cu = 0;
        if (hipGetDevice(&dev) != hipSuccess || hipDeviceGetAttribute(&cus, hipDeviceAttributeMultiprocessorCount, dev) != hipSuccess) { grid = -1; return; }
        if (hipFuncSetAttribute((const void*)hybrid_fwd, hipFuncAttributeMaxDynamicSharedMemorySize, LDS_BYTES) != hipSuccess) { fprintf(stderr, "kernel_launch: hipFuncSetAttribute failed\n"); grid = -1; return; }
        if (hipOccupancyMaxActiveBlocksPerMultiprocessor(&per_cu, (const void*)hybrid_fwd, NWAVES * 64, LDS_BYTES) != hipSuccess || per_cu < 1)
            fprintf(stderr, "kernel_launch: note: occupancy query reports %d workgroups per CU\n", per_cu);
        (void)hipGetLastError();
        grid = cus;
    }
    if (grid < 0) return;
    if (hipMemsetAsync((char*)d_ws + WS_CTL, 0, CTL_ZERO_BYTES, stream) != hipSuccess) { fprintf(stderr, "kernel_launch: hipMemsetAsync failed\n"); return; }
    Args a{};
    a.in[0] = (const float*)d_in[0]; a.in[1] = (const float*)d_in[1]; a.pos = (const int*)d_in[2];
    for (int i = 3; i < 19; ++i) a.in[i - 1] = (const float*)d_in[i];
    a.in[18] = nullptr;
    a.out = (float*)d_out; a.ws = (unsigned char*)d_ws;
    hipLaunchKernelGGL(hybrid_fwd, dim3(grid), dim3(NWAVES * 64), LDS_BYTES, stream, a);
    const hipError_t le = hipPeekAtLastError();
    if (le != hipSuccess) fprintf(stderr, "kernel_launch: launch failed: %s\n", hipGetErrorName(le));
}
```

```cpp
#include <hip/hip_runtime.h>
#include <cstdio>
#include <cstdint>
namespace pg8 {
#define PG8_LAS __attribute__((address_space(3)))
typedef unsigned short bf16_t;
typedef short bf16x8 __attribute__((ext_vector_type(8)));
typedef float f32x4 __attribute__((ext_vector_type(4)));
typedef unsigned u32x4 __attribute__((ext_vector_type(4)));
constexpr int BM = 256, BK = 64, HALF = 128, HTB = HALF * BK * 2  , STAGE_BYTES = 8 * HTB, NXCD = 8, WGM = 8;

__host__ __device__ __forceinline__ int lds_byte(int r, int c) { const int st = (r >> 4) * 2 + (c >> 5), rr = r & 15, cc = c & 31, ob = rr * 64 + cc * 2; return st * 1024 + (ob ^ (((ob >> 9) & 1) << 5)); }
__host__ __device__ __forceinline__ void stage_rc(int b, int& R, int& C) { const int st = b / 1024, sb = b % 1024, swz = sb ^ (((sb >> 9) & 1) << 5); R = (st >> 1) * 16 + swz / 64; C = (st & 1) * 32 + (swz % 64) / 2; }
__host__ __device__ __forceinline__ int perm32(int rho) { const int n = rho >> 4, i = rho & 15; return 8 * (i >> 2) + 4 * n + (i & 3); }

struct Unit { int pm, pn; };
struct Gemm { const bf16_t* A; const bf16_t* Bt; int M, N, K; };

struct StaticOrder {
    int nM, nN, nwg, G, c;
    __host__ __device__ void init(int M, int N, int G_, int c_) { nM = M / BM; nN = N / BM; nwg = nM * nN; G = G_; c = c_; }
    __host__ __device__ bool next(int i, Unit& u) const {
        const long L = (long)i * G + c; if (L >= nwg) return false;
        int wgid = (int)L; { const int q = nwg / NXCD, r = nwg % NXCD, xcd = wgid % NXCD, off = wgid / NXCD; wgid = (xcd < r ? xcd * (q + 1) : r * (q + 1) + (xcd - r) * q) + off; }
        const int nig = WGM * nN, gid = wgid / nig, fm = gid * WGM, gsz = (nM - fm) < WGM ? (nM - fm) : WGM;
        u.pm = fm + ((wgid % nig) % gsz); u.pn = (wgid % nig) / gsz; return true;
    }
    __device__ __forceinline__ void a_ready(const Unit&) const {}
    __device__ __forceinline__ void done(const Unit&) const {}
};

__device__ __forceinline__ unsigned cvt_pk_bf16(float lo, float hi) { unsigned r; asm volatile("v_cvt_pk_bf16_f32 %0, %1, %2" : "=v"(r) : "v"(lo), "v"(hi)); return r; }
typedef float f32x2 __attribute__((ext_vector_type(2)));
template <class Epi, class Sched, bool ALIGN_EPI = false, bool SP2 = false>
__device__ __forceinline__ void gemm_phase(PG8_LAS unsigned char* lds, const Gemm g, const Sched& S, const Epi& E) {
    int tid_ = threadIdx.x; asm volatile("" : "+v"(tid_));
    const int tid = tid_, wid = __builtin_amdgcn_readfirstlane(tid >> 6), lane = tid & 63, wr = wid >> 2, wc = wid & 3, fr = lane & 15, fq = lane >> 4;
    const int K = g.K, nt = K / BK;
    unsigned voffA[2], voffB[2];
#pragma unroll
    for (int i = 0; i < 2; ++i) { int R, C; stage_rc(tid * 16 + i * 8192, R, C); const int Rb = Epi::PERM ? ((R & ~31) + perm32(R & 31)) : R;
        voffA[i] = (unsigned)(R * K + C) * 2u; voffB[i] = (unsigned)(Rb * K + C) * 2u; }
    const size_t kstep = (size_t)(BK * 2);
    const size_t hstep = (size_t)HALF * K * 2;
    const size_t tstep = 2 * hstep;
    const unsigned ldsw = (unsigned)wid * 1024u;
    const int aoff = lds_byte(wr * 64 + fr, fq * 8), boff = lds_byte(wc * 32 + fr, fq * 8);
#define PG8_SA(b, h) (((b) * 2 + (h)) * HTB)
#define PG8_SB(b, h) ((4 + (b) * 2 + (h)) * HTB)
#define PG8_STAGE(bufoff, gbase, voff) do { _Pragma("unroll") for (int _i = 0; _i < 2; ++_i) \
        __builtin_amdgcn_global_load_lds((const unsigned*)((const char*)(gbase) + (voff)[_i]), (PG8_LAS unsigned*)(lds + (bufoff) + ldsw + _i * 8192), 16, 0, 0); } while (0)
#define PG8_LDA(dst, b, h) do { _Pragma("unroll") for (int m = 0; m < 4; ++m) _Pragma("unroll") for (int k = 0; k < 2; ++k) dst[m][k] = *(const PG8_LAS bf16x8*)(lds + PG8_SA(b, h) + aoff + m * 2048 + k * 1024); } while (0)
#define PG8_LDB(dst, b, h) do { _Pragma("unroll") for (int n = 0; n < 2; ++n) _Pragma("unroll") for (int k = 0; k < 2; ++k) dst[n][k] = *(const PG8_LAS bf16x8*)(lds + PG8_SB(b, h) + boff + n * 2048 + k * 1024); } while (0)
#define PG8_MMA(ai, bj, At, Bt) do { __builtin_amdgcn_s_setprio(1); _Pragma("unroll") for (int m = 0; m < 4; ++m) _Pragma("unroll") for (int n = 0; n < 2; ++n) _Pragma("unroll") for (int k = 0; k < 2; ++k) \
        acc[ai][bj][m][n] = __builtin_amdgcn_mfma_f32_16x16x32_bf16(Bt[n][k], At[m][k], acc[ai][bj][m][n], 0, 0, 0); __builtin_amdgcn_s_setprio(0); } while (0)
#define PG8_WAIT_V(n) asm volatile("s_waitcnt vmcnt(" #n ")" ::: "memory")
#define PG8_WAIT_L(n) asm volatile("s_waitcnt lgkmcnt(" #n ")" ::: "memory")
#define PG8_BAR __builtin_amdgcn_s_barrier()
#define PG8_SCHED __builtin_amdgcn_sched_barrier(0)
    Unit cur, nxt; int ui = 0;
    if (!S.next(0, cur)) return;
    f32x4 acc[2][2][4][2];
#pragma unroll
    for (int a = 0; a < 2; ++a)
#pragma unroll
        for (int b = 0; b < 2; ++b)
#pragma unroll
            for (int m = 0; m < 4; ++m)
#pragma unroll
                for (int n = 0; n < 2; ++n) acc[a][b][m][n] = (f32x4){0.f, 0.f, 0.f, 0.f};
    bf16x8 At[4][2], B0[2][2], B1[2][2];
    const char* cA = (const char*)g.A + (size_t)cur.pm * tstep; const char* cB = (const char*)g.Bt + (size_t)cur.pn * tstep;
    S.a_ready(cur);
    if constexpr (SP2) {
        PG8_STAGE(PG8_SB(0, 0), cB, voffB); PG8_STAGE(PG8_SB(0, 1), cB + hstep, voffB); PG8_STAGE(PG8_SA(0, 0), cA, voffA); PG8_STAGE(PG8_SA(0, 1), cA + hstep, voffA);
        if (wr == 1) PG8_BAR;
        PG8_WAIT_V(2); PG8_BAR;
        PG8_STAGE(PG8_SB(1, 0), cB + kstep, voffB); PG8_STAGE(PG8_SA(1, 0), cA + kstep, voffA); PG8_STAGE(PG8_SB(1, 1), cB + hstep + kstep, voffB);
        PG8_WAIT_V(6); PG8_BAR;
    } else {
        PG8_STAGE(PG8_SB(0, 0), cB, voffB); PG8_STAGE(PG8_SA(0, 0), cA, voffA); PG8_STAGE(PG8_SB(0, 1), cB + hstep, voffB); PG8_STAGE(PG8_SA(0, 1), cA + hstep, voffA);
        if (wr == 1) PG8_BAR;
        PG8_WAIT_V(4); PG8_BAR;
        PG8_STAGE(PG8_SB(1, 0), cB + kstep, voffB); PG8_STAGE(PG8_SA(1, 0), cA + kstep, voffA); PG8_STAGE(PG8_SB(1, 1), cB + hstep + kstep, voffB);
        PG8_WAIT_V(6); PG8_BAR;
    }
    for (;;) {
        const bool has_next = S.next(ui + 1, nxt);
        const char* nA = has_next ? (const char*)g.A + (size_t)nxt.pm * tstep : cA; const char* nB = has_next ? (const char*)g.Bt + (size_t)nxt.pn * tstep : cB;
        for (int t = 0; t < nt; t += 2) {
            const bool last = (t == nt - 2);
            const char* a1 = cA + (size_t)(t + 1) * kstep;
            const char* a2 = last ? nA : cA + (size_t)(t + 2) * kstep; const char* b2 = last ? nB : cB + (size_t)(t + 2) * kstep;
            const char* a3 = a2 + kstep; const char* b3 = b2 + kstep;
            if (last && has_next) S.a_ready(nxt);
            if constexpr (SP2) {
            PG8_LDB(B0, 0, 0); PG8_LDB(B1, 0, 1); PG8_SCHED; PG8_LDA(At, 0, 0); PG8_STAGE(PG8_SA(1, 1), a1 + hstep, voffA);
            PG8_WAIT_V(8); PG8_WAIT_L(0); PG8_BAR; PG8_MMA(0, 0, At, B0); PG8_MMA(0, 1, At, B1); PG8_BAR; PG8_SCHED;
            PG8_LDA(At, 0, 1); PG8_STAGE(PG8_SB(0, 0), b2, voffB); PG8_STAGE(PG8_SB(0, 1), b2 + hstep, voffB); PG8_STAGE(PG8_SA(0, 0), a2, voffA);
            PG8_WAIT_V(8); PG8_WAIT_L(0); PG8_BAR; PG8_MMA(1, 0, At, B0); PG8_MMA(1, 1, At, B1); PG8_BAR; PG8_SCHED;
            PG8_LDB(B0, 1, 0); PG8_LDB(B1, 1, 1); PG8_SCHED; PG8_LDA(At, 1, 0); PG8_STAGE(PG8_SA(0, 1), a2 + hstep, voffA);
            PG8_WAIT_V(8); PG8_WAIT_L(0); PG8_BAR; PG8_MMA(0, 0, At, B0); PG8_MMA(0, 1, At, B1); PG8_BAR; PG8_SCHED;
            PG8_LDA(At, 1, 1); PG8_STAGE(PG8_SB(1, 0), b3, voffB); PG8_STAGE(PG8_SB(1, 1), b3 + hstep, voffB); PG8_STAGE(PG8_SA(1, 0), a3, voffA);
            PG8_WAIT_V(8); PG8_WAIT_L(0); PG8_BAR; PG8_MMA(1, 0, At, B0); PG8_MMA(1, 1, At, B1); PG8_BAR; PG8_SCHED;
            } else {
            PG8_LDB(B0, 0, 0); PG8_SCHED; PG8_LDA(At, 0, 0); PG8_STAGE(PG8_SA(1, 1), a1 + hstep, voffA);
            PG8_WAIT_L(8); PG8_BAR; PG8_WAIT_L(0); PG8_MMA(0, 0, At, B0); PG8_BAR; PG8_SCHED;
            PG8_LDB(B1, 0, 1); PG8_STAGE(PG8_SB(0, 0), b2, voffB);
            PG8_BAR; PG8_WAIT_L(0); PG8_MMA(0, 1, At, B1); PG8_BAR;
            PG8_LDA(At, 0, 1); PG8_STAGE(PG8_SA(0, 0), a2, voffA);
            PG8_BAR; PG8_WAIT_L(0); PG8_MMA(1, 0, At, B0); PG8_BAR; PG8_SCHED;
            PG8_STAGE(PG8_SB(0, 1), b2 + hstep, voffB);
            PG8_WAIT_V(6); PG8_BAR; PG8_MMA(1, 1, At, B1); PG8_BAR;
            PG8_LDB(B0, 1, 0); PG8_SCHED; PG8_LDA(At, 1, 0); PG8_STAGE(PG8_SA(0, 1), a2 + hstep, voffA);
            PG8_WAIT_L(8); PG8_BAR; PG8_WAIT_L(0); PG8_MMA(0, 0, At, B0); PG8_BAR; PG8_SCHED;
            PG8_LDB(B1, 1, 1); PG8_STAGE(PG8_SB(1, 0), b3, voffB);
            PG8_BAR; PG8_WAIT_L(0); PG8_MMA(0, 1, At, B1); PG8_BAR;
            PG8_LDA(At, 1, 1); PG8_STAGE(PG8_SA(1, 0), a3, voffA);
            PG8_BAR; PG8_WAIT_L(0); PG8_MMA(1, 0, At, B0); PG8_BAR; PG8_SCHED;
            PG8_STAGE(PG8_SB(1, 1), b3 + hstep, voffB);
            PG8_WAIT_V(6); PG8_BAR; PG8_MMA(1, 1, At, B1); PG8_BAR;
            }
        }
        if constexpr (ALIGN_EPI) { if (wr == 0) PG8_BAR; }
        if constexpr (!Epi::AFTER_DRAIN) { E(acc, cur, wr, wc, fr, fq); S.done(cur); }
        if (!has_next) break;
#pragma unroll
        for (int a = 0; a < 2; ++a)
#pragma unroll
            for (int b = 0; b < 2; ++b)
#pragma unroll
                for (int m = 0; m < 4; ++m)
#pragma unroll
                    for (int n = 0; n < 2; ++n) acc[a][b][m][n] = (f32x4){0.f, 0.f, 0.f, 0.f};
        cur = nxt; cA = nA; cB = nB; ++ui;
        if constexpr (ALIGN_EPI) { if (wr == 1) PG8_BAR; }
    }
    PG8_WAIT_V(0);
    if constexpr (!ALIGN_EPI) { if (wr == 0) PG8_BAR; }
    PG8_BAR;
    if constexpr (Epi::AFTER_DRAIN) { E.fused(acc, cur, wr, wc, fr, fq, lds, wid, lane); S.done(cur); }
#undef PG8_SA
#undef PG8_SB
#undef PG8_STAGE
#undef PG8_LDA
#undef PG8_LDB
#undef PG8_MMA
#undef PG8_WAIT_V
#undef PG8_WAIT_L
#undef PG8_BAR
#undef PG8_SCHED
}
}

#ifndef PG8_SP2
#define PG8_SP2 true
#endif
#ifndef PG8_ALIGN
#define PG8_ALIGN true
#endif
#define GAS __attribute__((address_space(1)))
#define LAS __attribute__((address_space(3)))
typedef unsigned short bf16;
typedef unsigned v4u __attribute__((ext_vector_type(4)));
typedef float f32x4 __attribute__((ext_vector_type(4)));
typedef short bf16x8 __attribute__((ext_vector_type(8)));
typedef GAS unsigned gu32;
typedef GAS unsigned long long gu64;
#define RLX_AGENT __ATOMIC_RELAXED, __HIP_MEMORY_SCOPE_AGENT
#define LDS_WAIT() asm volatile("s_waitcnt lgkmcnt(0)" ::: "memory")
#define VM_WAIT() asm volatile("s_waitcnt vmcnt(0)" ::: "memory")
__device__ __forceinline__ unsigned long long rt() { return __builtin_amdgcn_s_memrealtime(); }
__device__ __forceinline__ unsigned f2bf(float f) { unsigned u = __builtin_bit_cast(unsigned, f); return (u + 0x7fffu + ((u >> 16) & 1u)) >> 16; }
__device__ __forceinline__ unsigned pk2(float lo, float hi) { return f2bf(lo) | (f2bf(hi) << 16); }

#define XB_TMO      128
#define XB_XCNT(j)  (256  + 64 * (j))
#define XB_XSUB(j)  (1280 + 64 * (j))
#define XB_XGEN(j)  (2304 + 64 * (j))
#define XB_TOP      3328
#define XB_TOPGEN   3392
#define XCD_BAR_WORDS 3456
#define XB_SPIN_CAP (1u << 22)

__device__ __forceinline__ unsigned xb_ld(unsigned* p)              { return __hip_atomic_load(p, __ATOMIC_RELAXED, __HIP_MEMORY_SCOPE_AGENT); }
__device__ __forceinline__ unsigned xb_add(unsigned* p, unsigned v) { return __hip_atomic_fetch_add(p, v, __ATOMIC_RELAXED, __HIP_MEMORY_SCOPE_AGENT); }
__device__ __forceinline__ unsigned xb_xcc_id() { return (unsigned)__builtin_amdgcn_s_getreg((3 << 11) | 20) & 0xFu; }
#define XB_SPIN(cond, bar) do { unsigned _sp = 0; while (cond) { __builtin_amdgcn_s_sleep(1); \
    if ((++_sp & 255u) == 0u) { if (xb_ld(&(bar)[XB_TMO])) break; if (_sp > XB_SPIN_CAP) { atomicAdd(&(bar)[XB_TMO], 1u); break; } } } } while (0)

struct XcdBarrier {
    unsigned* bar; unsigned x;
    volatile LAS unsigned* st;
};

__device__ __forceinline__ XcdBarrier xcd_barrier_post(unsigned* bar, volatile LAS unsigned* st) {
    XcdBarrier b; b.bar = bar; b.x = xb_xcc_id(); b.st = st;
    if (threadIdx.x == 0) (void)xb_add(&bar[XB_XCNT(b.x)], 1u);
    return b;
}
__device__ __forceinline__ void xcd_barrier_complete(unsigned* bar, unsigned x, unsigned& nloc, unsigned& nx) {
    const unsigned G = gridDim.x * gridDim.y * gridDim.z;
    unsigned sum, cnt, mine, sp = 0u;
    for (;;) {
        sum = 0u; cnt = 0u; mine = 0u;
#pragma unroll
        for (unsigned j = 0; j < 16; ++j) { const unsigned c = xb_ld(&bar[XB_XCNT(j)]); sum += c; cnt += (c > 0u) ? 1u : 0u; mine = (j == x) ? c : mine; }
        if (sum == G) break;
        __builtin_amdgcn_s_sleep(1);
        if ((++sp & 255u) == 0u) { if (xb_ld(&bar[XB_TMO])) break; if (sp > XB_SPIN_CAP) { atomicAdd(&bar[XB_TMO], 1u); break; } }
    }
    nloc = mine > 0u ? mine : 1u; nx = cnt > 0u ? cnt : 1u;
}

__device__ __forceinline__ void xcd_barrier(const XcdBarrier& b) {
    asm volatile("s_waitcnt vmcnt(0)" ::: "memory");
    __syncthreads();
    if (threadIdx.x == 0) {
        unsigned* bar = b.bar;
        __builtin_amdgcn_s_waitcnt(0);
        unsigned nloc = b.st[0], nx = b.st[1];
        if (nloc == 0u) { xcd_barrier_complete(bar, b.x, nloc, nx); b.st[0] = nloc; b.st[1] = nx; }
        const unsigned old = xb_add(&bar[XB_XSUB(b.x)], 1u);
        const unsigned gen = old / nloc;
        if (old + 1u == (gen + 1u) * nloc) {
            __builtin_amdgcn_fence(__ATOMIC_RELEASE, "agent");
            asm volatile("s_waitcnt vmcnt(0)" ::: "memory");
            const unsigned og = xb_add(&bar[XB_TOP], 1u);
            const unsigned tg = og / nx;
            if (og + 1u == (tg + 1u) * nx) xb_add(&bar[XB_TOPGEN], 1u);
            else XB_SPIN(xb_ld(&bar[XB_TOPGEN]) == tg, bar);
            __builtin_amdgcn_fence(__ATOMIC_ACQUIRE, "agent");
            xb_add(&bar[XB_XGEN(b.x)], 1u);
            asm volatile("s_waitcnt vmcnt(0)" ::: "memory");
        } else {
            XB_SPIN(xb_ld(&bar[XB_XGEN(b.x)]) == gen, bar);
            __builtin_amdgcn_fence(__ATOMIC_ACQUIRE, "agent");
            asm volatile("s_waitcnt vmcnt(0)" ::: "memory");
        }
    }
    __syncthreads();
}

namespace mm {
typedef short bf16x8 __attribute__((ext_vector_type(8)));
typedef short s16x4 __attribute__((ext_vector_type(4)));
typedef float f32x16 __attribute__((ext_vector_type(16)));
typedef unsigned u32x4 __attribute__((ext_vector_type(4)));
#define MM_LAS __attribute__((address_space(3)))
#define MFMA32(a, b, c) __builtin_amdgcn_mfma_f32_32x32x16_bf16((a), (b), (c), 0, 0, 0)
__device__ __forceinline__ int crow(int i, int h) { return (i & 3) + 8 * (i >> 2) + 4 * h; }
template <int ROWB, int PITCH, int NROWS> __device__ __forceinline__ void stage_tile(MM_LAS unsigned char* dst, const unsigned short* src, long ld, int tid, int zero_below = 0) {
    constexpr int CPR = ROWB / 16, TOT = NROWS * CPR, PER = TOT / 512, B = PER > 8 ? 8 : PER;
    static_assert(TOT % 512 == 0 && PER % B == 0 && PITCH % 16 == 0, "stage_tile shape");
#pragma unroll
    for (int b0 = 0; b0 < PER; b0 += B) {
        u32x4 v[B];
#pragma unroll
        for (int c = 0; c < B; ++c) { const int id = tid + 512 * (b0 + c), row = id / CPR, ch = id % CPR;
            const int rl = row < zero_below ? zero_below : row;
            v[c] = *(const u32x4*)(src + (long)rl * ld + ch * 8);
            if (row < zero_below) v[c] = (u32x4){0u, 0u, 0u, 0u}; }
#pragma unroll
        for (int c = 0; c < B; ++c) { const int id = tid + 512 * (b0 + c), row = id / CPR, ch = id % CPR;
            *(MM_LAS u32x4*)(dst + row * PITCH + 16 * ch) = v[c]; }
    }
}
template <int PITCH> __device__ __forceinline__ bf16x8 frag_row(const MM_LAS unsigned char* t, int row, int kchunk) { return *(const MM_LAS bf16x8*)(t + row * PITCH + 16 * kchunk); }
__device__ __forceinline__ s16x4 vtr(const MM_LAS unsigned char* p) { typedef short v4i16_t __attribute__((ext_vector_type(4))); return __builtin_bit_cast(s16x4, __builtin_amdgcn_ds_read_tr16_b64_v4i16((MM_LAS v4i16_t*)p)); }
template <int PITCH, bool PERM> __device__ __forceinline__ int tr_lane(int lane) {
    const int g1 = (lane >> 4) & 1, h = lane >> 5, q = (lane >> 2) & 3, p = lane & 3;
    return ((PERM ? 4 * h : 8 * h) + q) * PITCH + 2 * (16 * g1 + 4 * p);
}
template <int PITCH, bool PERM> __device__ __forceinline__ bf16x8 frag_tr(const MM_LAS unsigned char* t, int trl, int kbase, int nbase) {
    const MM_LAS unsigned char* p = t + trl + kbase * PITCH + 2 * nbase;
    const s16x4 lo = vtr(p), hi = vtr(p + (PERM ? 8 : 4) * PITCH);
    return (bf16x8){lo[0], lo[1], lo[2], lo[3], hi[0], hi[1], hi[2], hi[3]};
}
__device__ __forceinline__ unsigned cvtpk(float lo, float hi) { typedef float f2_t __attribute__((ext_vector_type(2))); typedef __bf16 b2_t __attribute__((ext_vector_type(2))); f2_t v = {lo, hi}; b2_t b = __builtin_convertvector(v, b2_t); return __builtin_bit_cast(unsigned, b); }
__device__ __forceinline__ bf16x8 pack_step(const f32x16& x, int s) {
    u32x4 p; p.x = cvtpk(x[8 * s], x[8 * s + 1]); p.y = cvtpk(x[8 * s + 2], x[8 * s + 3]); p.z = cvtpk(x[8 * s + 4], x[8 * s + 5]); p.w = cvtpk(x[8 * s + 6], x[8 * s + 7]);
    return __builtin_bit_cast(bf16x8, p);
}
__device__ __forceinline__ unsigned short f2bf_(float f) { return (unsigned short)(cvtpk(f, 0.f) & 0xffffu); }
}

constexpr int NWAVES = 8;
constexpr int M = 16384, D = 2048, NIN = 9728, DFF = 5632, NMEM = 256;
constexpr float EPS = 1e-6f;
constexpr size_t MiB = 1u << 20;
constexpr size_t WS_CTL = 0, CTL_ZERO_BYTES = 1 * MiB;
constexpr size_t WS_SSQ1 = 1 * MiB, WS_SSQ2 = 3 * MiB, WS_SSQ3 = 5 * MiB;
constexpr size_t WS_MEMN = 7 * MiB;
constexpr size_t WS_KVM = 8 * MiB;
constexpr size_t WS_COSS = 9 * MiB, WS_SINS = 9 * MiB + 512 * 1024;
constexpr size_t WS_COSR = 10 * MiB, WS_SINR = 18 * MiB;
constexpr size_t WS_W = 26 * MiB;
constexpr size_t W_IN = WS_W, W_UR = WS_W + 38 * MiB, W_US = WS_W + 42 * MiB, W_O = WS_W + 46 * MiB, W_XQ = WS_W + 54 * MiB,
                 W_XKV = WS_W + 56 * MiB, W_XO = WS_W + 60 * MiB, W_GU = WS_W + 62 * MiB, W_DN = WS_W + 106 * MiB;
constexpr size_t WS_ACT = 154 * MiB;
constexpr size_t A_QR = WS_ACT + 0 * MiB, A_QS = WS_ACT + 32 * MiB, A_KR = WS_ACT + 64 * MiB, A_KD = WS_ACT + 96 * MiB, A_VR = WS_ACT + 128 * MiB,
                 A_GR = WS_ACT + 160 * MiB, A_KS = WS_ACT + 192 * MiB, A_VS = WS_ACT + 200 * MiB, A_SGR = WS_ACT + 208 * MiB, A_SGS = WS_ACT + 272 * MiB;
constexpr size_t A_MERGED = WS_ACT + 64 * MiB, A_H1B = WS_ACT + 128 * MiB, A_XQ = WS_ACT + 0 * MiB, A_XA = WS_ACT + 16 * MiB, A_H2B = WS_ACT + 64 * MiB,
                 A_ACTF = WS_ACT + 160 * MiB;
constexpr size_t WS_END = 490 * MiB;
static_assert(A_ACTF + (size_t)M * DFF * 2 <= WS_END && WS_END <= 512 * MiB, "d_ws map");
constexpr int CW_BAR = 4096;
constexpr int RING_OFF = 0, RING_BYTES = 131072;
constexpr int LDSCTL_OFF = 155648, MISC_OFF = LDSCTL_OFF + 320;
constexpr int LDS_BYTES = 163840;

typedef pg8::f32x4 f4;
typedef unsigned u4 __attribute__((ext_vector_type(4)));
typedef unsigned u2 __attribute__((ext_vector_type(2)));
__device__ __forceinline__ float bf2f(unsigned short b) { return __uint_as_float((unsigned)b << 16); }
__device__ __forceinline__ float bflo(unsigned w) { return __uint_as_float(w << 16); }
__device__ __forceinline__ float bfhi(unsigned w) { return __uint_as_float(w & 0xffff0000u); }
__device__ __forceinline__ float wave_sum(float v) {
#pragma unroll
    for (int o = 1; o < 64; o <<= 1) v += __shfl_xor(v, o);
    return v;
}
__device__ __forceinline__ float wave_max(float v) {
#pragma unroll
    for (int o = 1; o < 64; o <<= 1) v = fmaxf(v, __shfl_xor(v, o));
    return v;
}
__device__ __forceinline__ float sigmoidf_(float v) { return 1.0f / (1.0f + __expf(-v)); }
__device__ __forceinline__ u4 pack8(const f4& a, const f4& b) {
    u4 w; w.x = pg8::cvt_pk_bf16(a[0], a[1]); w.y = pg8::cvt_pk_bf16(a[2], a[3]); w.z = pg8::cvt_pk_bf16(b[0], b[1]); w.w = pg8::cvt_pk_bf16(b[2], b[3]); return w;
}
__device__ __forceinline__ float log2_gamma(int h) {
    return h == 0 ? -0.045803689613124704f : h == 1 ? -0.022720076500083645f : h == 2 ? -0.011315313227834157f : -0.005646563141142062f;
}

__device__ __forceinline__ void p0_transpose_item(const float* W, int K, int N, bf16* WT, int kb, int nb, int drow0, const float* gk, LAS float* scr, int lane) {
    const int k0 = 64 * kb, n0 = 32 * nb;
#pragma unroll 8
    for (int i = 0; i < 32; ++i) { const int kk = 2 * i + (lane >> 5); float w = W[(size_t)(k0 + kk) * N + n0 + (lane & 31)]; if (gk) w *= gk[k0 + kk]; scr[kk * 33 + (lane & 31)] = w; }
    LDS_WAIT(); asm volatile("" ::: "memory");
    const int c = lane & 7;
#pragma unroll
    for (int j = 0; j < 4; ++j) { const int n = (lane >> 3) + 8 * j; const LAS float* s = scr + (8 * c) * 33 + n;
        v4u o; o.x = pk2(s[0 * 33], s[1 * 33]); o.y = pk2(s[2 * 33], s[3 * 33]); o.z = pk2(s[4 * 33], s[5 * 33]); o.w = pk2(s[6 * 33], s[7 * 33]);
        *(GAS v4u*)(WT + (size_t)(drow0 + n) * K + k0 + 8 * c) = o; }
    LDS_WAIT(); asm volatile("" ::: "memory");
}
__device__ __forceinline__ void rms_row_to_bf16(const float* xrow, const float* g, bf16* orow, int lane) {
    const GAS f4* xr = (const GAS f4*)xrow + lane; const GAS f4* gr = (const GAS f4*)g + lane;
    f4 v[8]; float s = 0.f;
#pragma unroll
    for (int j = 0; j < 8; ++j) { v[j] = xr[64 * j]; s += (v[j].x * v[j].x + v[j].y * v[j].y) + (v[j].z * v[j].z + v[j].w * v[j].w); }
    const float rstd = 1.0f / sqrtf(wave_sum(s) * (1.f / 2048.f) + EPS);
    GAS unsigned long long* o8 = (GAS unsigned long long*)orow + lane;
#pragma unroll
    for (int j = 0; j < 8; ++j) { const f4 gg = gr[64 * j]; o8[64 * j] = (unsigned long long)pk2(v[j].x * rstd * gg.x, v[j].y * rstd * gg.y) | ((unsigned long long)pk2(v[j].z * rstd * gg.z, v[j].w * rstd * gg.w) << 32); }
}

#define EPI_FENCE() asm volatile("" ::: "memory")
struct EpiInProj {
    static constexpr bool PERM = true, AFTER_DRAIN = false;
    unsigned char* ws;
    __device__ __forceinline__ void operator()(const f4 (&acc)[2][2][4][2], const pg8::Unit& u, int wr, int wc, int fr0, int fq0) const {
        int fr = fr0, fq = fq0; asm volatile("" : "+v"(fr), "+v"(fq));
        const int pn = u.pn, cl = wc * 32 + 8 * fq, row0 = u.pm * 256 + wr * 64 + fr;
        const float* cosr = (const float*)(ws + WS_COSR); const float* sinr = (const float*)(ws + WS_SINR);
        const float* coss = (const float*)(ws + WS_COSS); const float* sins = (const float*)(ws + WS_SINS);
        if (pn < 8) {
            const bool isk = pn >= 4; const int hh = pn & 3;
            bf16* dst = (bf16*)(ws + (isk ? A_KR : A_QR)); bf16* dkd = (bf16*)(ws + A_KD);
            const float l2g = log2_gamma(hh);
#pragma unroll
            for (int aim = 0; aim < 4; ++aim) {
                const int ai = aim >> 1;
                f4 cs[2][4];
#pragma unroll
                for (int mm = 0; mm < 2; ++mm) { const int m = (aim & 1) * 2 + mm; const size_t to = (size_t)(row0 + ai * 128 + m * 16) * 128 + cl;
                    cs[mm][0] = *(const f4*)(cosr + to); cs[mm][1] = *(const f4*)(cosr + to + 4); cs[mm][2] = *(const f4*)(sinr + to); cs[mm][3] = *(const f4*)(sinr + to + 4); }
                EPI_FENCE();
#pragma unroll
                for (int mm = 0; mm < 2; ++mm) { const int m = (aim & 1) * 2 + mm; const int row = row0 + ai * 128 + m * 16;
                    const f4 c0 = cs[mm][0], c1 = cs[mm][1], s0 = cs[mm][2], s1 = cs[mm][3];
                    const f4 a0 = acc[ai][0][m][0], a1 = acc[ai][0][m][1], b0 = acc[ai][1][m][0], b1 = acc[ai][1][m][1];
                    f4 y0 = a0 * c0 - b0 * s0, y1 = a1 * c1 - b1 * s1, z0 = b0 * c0 + a0 * s0, z1 = b1 * c1 + a1 * s1;
                    if (isk) { y0 = y0 * 0.0625f; y1 = y1 * 0.0625f; z0 = z0 * 0.0625f; z1 = z1 * 0.0625f; }
                    bf16* p = dst + (size_t)row * 1024 + hh * 256 + cl;
                    *(u4*)p = pack8(y0, y1); *(u4*)(p + 128) = pack8(z0, z1);
                    if (isk) { const float dec = exp2f((float)(127 - (row & 127)) * l2g);
                        bf16* q = dkd + (size_t)row * 1024 + hh * 256 + cl;
                        *(u4*)q = pack8(y0 * dec, y1 * dec); *(u4*)(q + 128) = pack8(z0 * dec, z1 * dec); } }
                EPI_FENCE();
            }
        } else if (pn < 16 || pn >= 21) {
            bf16* dst; int ld, colb, mode;
            if (pn < 12) { dst = (bf16*)(ws + A_VR); ld = 1024; colb = (pn - 8) * 256; mode = 0; }
            else if (pn < 16) { dst = (bf16*)(ws + A_GR); ld = 1024; colb = (pn - 12) * 256; mode = 1; }
            else if (pn == 21) { dst = (bf16*)(ws + A_VS); ld = 256; colb = 0; mode = 0; }
            else if (pn < 30) { dst = (bf16*)(ws + A_SGR); ld = 2048; colb = (pn - 22) * 256; mode = 2; }
            else { dst = (bf16*)(ws + A_SGS); ld = 2048; colb = (pn - 30) * 256; mode = 2; }
#pragma unroll
            for (int ai = 0; ai < 2; ++ai)
#pragma unroll
                for (int m = 0; m < 4; ++m) { const int row = row0 + ai * 128 + m * 16;
#pragma unroll
                    for (int bj = 0; bj < 2; ++bj) { f4 v0 = acc[ai][bj][m][0], v1 = acc[ai][bj][m][1];
                        if (mode != 0) {
#pragma unroll
                            for (int e = 0; e < 4; ++e) { const float g0 = sigmoidf_(v0[e]), g1 = sigmoidf_(v1[e]); v0[e] = mode == 1 ? v0[e] * g0 : g0; v1[e] = mode == 1 ? v1[e] * g1 : g1; } }
                        *(u4*)(dst + (size_t)row * ld + colb + bj * 128 + cl) = pack8(v0, v1); } }
        } else {
            const bool isq = pn < 20;
            bf16* dst = (bf16*)(ws + (isq ? A_QS : A_KS)); const int ld = isq ? 1024 : 256, colb = isq ? (pn - 16) * 256 : 0;
            const int hc = cl & 63;
            const float sc = isq ? 0.125f * 1.4426950408889634f : 1.0f;
            const float fc = (hc < 16) ? 1.f : 0.f, fs = (hc == 0) ? -1.f : (hc == 8) ? 1.f : 0.f;
#pragma unroll
            for (int ai = 0; ai < 2; ++ai) {
                f4 cs[4][4];
#pragma unroll
                for (int m = 0; m < 4; ++m) { const size_t to = (size_t)(row0 + ai * 128 + m * 16) * 8;
                    cs[m][0] = *(const f4*)(coss + to); cs[m][1] = *(const f4*)(coss + to + 4); cs[m][2] = *(const f4*)(sins + to); cs[m][3] = *(const f4*)(sins + to + 4); }
                EPI_FENCE();
#pragma unroll
                for (int m = 0; m < 4; ++m) { const int row = row0 + ai * 128 + m * 16;
                    const f4 c0 = cs[m][0], c1 = cs[m][1], s0 = cs[m][2], s1 = cs[m][3];
#pragma unroll
                    for (int bj = 0; bj < 2; ++bj) { f4 v0 = acc[ai][bj][m][0], v1 = acc[ai][bj][m][1]; f4 p0, p1;
#pragma unroll
                        for (int e = 0; e < 4; ++e) { p0[e] = __shfl_xor(v0[e], 16); p1[e] = __shfl_xor(v1[e], 16); }
                        v0 = v0 * ((c0 - 1.f) * fc + 1.f) + p0 * (s0 * fs); v1 = v1 * ((c1 - 1.f) * fc + 1.f) + p1 * (s1 * fs);
                        v0 = v0 * sc; v1 = v1 * sc;
                        *(u4*)(dst + (size_t)row * ld + colb + bj * 128 + cl) = pack8(v0, v1); } }
                EPI_FENCE();
            }
        }
    }
};
struct EpiPlain {
    static constexpr bool PERM = true, AFTER_DRAIN = false;
    bf16* O; int ldc;
    __device__ __forceinline__ void operator()(const f4 (&acc)[2][2][4][2], const pg8::Unit& u, int wr, int wc, int fr0, int fq0) const {
        int fr = fr0, fq = fq0; asm volatile("" : "+v"(fr), "+v"(fq));
        const int cl = wc * 32 + 8 * fq, row0 = u.pm * 256 + wr * 64 + fr;
#pragma unroll
        for (int ai = 0; ai < 2; ++ai)
#pragma unroll
            for (int m = 0; m < 4; ++m) { const int row = row0 + ai * 128 + m * 16;
#pragma unroll
                for (int bj = 0; bj < 2; ++bj) *(u4*)(O + (size_t)row * ldc + u.pn * 256 + bj * 128 + cl) = pack8(acc[ai][bj][m][0], acc[ai][bj][m][1]); }
    }
};
struct EpiUp {
    static constexpr bool PERM = true, AFTER_DRAIN = false;
    unsigned char* ws;
    __device__ __forceinline__ void operator()(const f4 (&acc)[2][2][4][2], const pg8::Unit& u, int wr, int wc, int fr0, int fq0) const {
        int fr = fr0, fq = fq0; asm volatile("" : "+v"(fr), "+v"(fq));
        const int w = u.pm >= 64 ? 1 : 0, pm = u.pm & 63, pn = u.pn & 7;
        const int cl = wc * 32 + 8 * fq, row0 = pm * 256 + wr * 64 + fr;
        const bf16* gate = (const bf16*)(ws + (w ? A_SGS : A_SGR)); bf16* mg = (bf16*)(ws + A_MERGED);
#pragma unroll
        for (int ai = 0; ai < 2; ++ai) {
            u4 g[4][2], p[4][2];
#pragma unroll
            for (int m = 0; m < 4; ++m)
#pragma unroll
                for (int bj = 0; bj < 2; ++bj) { const size_t off = (size_t)(row0 + ai * 128 + m * 16) * 2048 + pn * 256 + bj * 128 + cl;
                    g[m][bj] = *(const u4*)(gate + off); p[m][bj] = w ? *(const u4*)(mg + off) : (u4){0u, 0u, 0u, 0u}; }
            EPI_FENCE();
#pragma unroll
            for (int m = 0; m < 4; ++m)
#pragma unroll
                for (int bj = 0; bj < 2; ++bj) { const size_t off = (size_t)(row0 + ai * 128 + m * 16) * 2048 + pn * 256 + bj * 128 + cl;
                    const u4 gg = g[m][bj], pp = p[m][bj]; f4 v0 = acc[ai][bj][m][0], v1 = acc[ai][bj][m][1];
                    v0[0] = v0[0] * bflo(gg.x) + bflo(pp.x); v0[1] = v0[1] * bfhi(gg.x) + bfhi(pp.x); v0[2] = v0[2] * bflo(gg.y) + bflo(pp.y); v0[3] = v0[3] * bfhi(gg.y) + bfhi(pp.y);
                    v1[0] = v1[0] * bflo(gg.z) + bflo(pp.z); v1[1] = v1[1] * bfhi(gg.z) + bfhi(pp.z); v1[2] = v1[2] * bflo(gg.w) + bflo(pp.w); v1[3] = v1[3] * bfhi(gg.w) + bfhi(pp.w);
                    *(u4*)(mg + off) = pack8(v0, v1); }
            EPI_FENCE();
        }
    }
};
struct EpiResid {
    static constexpr bool PERM = true, AFTER_DRAIN = false;
    const float* base; float* out; bf16* hb; float* ssq; LAS float* xss;
    __device__ __forceinline__ void operator()(const f4 (&acc)[2][2][4][2], const pg8::Unit& u, int wr, int wc, int fr0, int fq0) const {
        int fr = fr0, fq = fq0; asm volatile("" : "+v"(fr), "+v"(fq));
        const int cl = wc * 32 + 8 * fq, row0 = u.pm * 256 + wr * 64 + fr;
        float ss[2][4];
#pragma unroll
        for (int ai = 0; ai < 2; ++ai) {
            f4 xr[4][2][2];
#pragma unroll
            for (int m = 0; m < 4; ++m)
#pragma unroll
                for (int bj = 0; bj < 2; ++bj) { const size_t off = (size_t)(row0 + ai * 128 + m * 16) * 2048 + u.pn * 256 + bj * 128 + cl;
                    xr[m][bj][0] = *(const f4*)(base + off); xr[m][bj][1] = *(const f4*)(base + off + 4); }
            EPI_FENCE();
#pragma unroll
            for (int m = 0; m < 4; ++m) { float s = 0.f;
#pragma unroll
                for (int bj = 0; bj < 2; ++bj) { const size_t off = (size_t)(row0 + ai * 128 + m * 16) * 2048 + u.pn * 256 + bj * 128 + cl;
                    const f4 h0 = xr[m][bj][0] + acc[ai][bj][m][0], h1 = xr[m][bj][1] + acc[ai][bj][m][1];
                    *(f4*)(out + off) = h0; *(f4*)(out + off + 4) = h1;
                    if (hb) *(u4*)(hb + off) = pack8(h0, h1);
                    s += (h0[0] * h0[0] + h0[1] * h0[1]) + (h0[2] * h0[2] + h0[3] * h0[3]) + (h1[0] * h1[0] + h1[1] * h1[1]) + (h1[2] * h1[2] + h1[3] * h1[3]); }
                s += __shfl_xor(s, 16); s += __shfl_xor(s, 32); ss[ai][m] = s; }
            EPI_FENCE();
        }
        if (fq == 0) {
#pragma unroll
            for (int ai = 0; ai < 2; ++ai)
#pragma unroll
                for (int m = 0; m < 4; ++m) xss[wc * 256 + ai * 128 + wr * 64 + m * 16 + fr] = ss[ai][m]; }
        asm volatile("s_waitcnt lgkmcnt(0)" ::: "memory"); __builtin_amdgcn_s_barrier(); asm volatile("" ::: "memory");
        const int t = (wr * 4 + wc) * 64 + fq * 16 + fr;
        if (t < 256) ssq[(size_t)(u.pm * 256 + t) * 8 + u.pn] = (xss[t] + xss[256 + t]) + (xss[512 + t] + xss[768 + t]);
    }
};
__device__ __forceinline__ float rstd_of(const f4& a, const f4& b) { return 1.0f / sqrtf(((a[0] + a[1]) + (a[2] + a[3]) + (b[0] + b[1]) + (b[2] + b[3])) * (1.f / 2048.f) + EPS); }
struct EpiRstd {
    static constexpr bool PERM = true, AFTER_DRAIN = false;
    bf16* O; int ldc; const float* ssq; float scale;
    __device__ __forceinline__ void operator()(const f4 (&acc)[2][2][4][2], const pg8::Unit& u, int wr, int wc, int fr0, int fq0) const {
        int fr = fr0, fq = fq0; asm volatile("" : "+v"(fr), "+v"(fq));
        const int cl = wc * 32 + 8 * fq, row0 = u.pm * 256 + wr * 64 + fr;
        f4 sq[2][4][2];
#pragma unroll
        for (int ai = 0; ai < 2; ++ai)
#pragma unroll
            for (int m = 0; m < 4; ++m) { const float* p = ssq + (size_t)(row0 + ai * 128 + m * 16) * 8; sq[ai][m][0] = *(const f4*)p; sq[ai][m][1] = *(const f4*)(p + 4); }
        EPI_FENCE();
#pragma unroll
        for (int ai = 0; ai < 2; ++ai)
#pragma unroll
            for (int m = 0; m < 4; ++m) { const int row = row0 + ai * 128 + m * 16; const float rs = rstd_of(sq[ai][m][0], sq[ai][m][1]) * scale;
#pragma unroll
                for (int bj = 0; bj < 2; ++bj) *(u4*)(O + (size_t)row * ldc + u.pn * 256 + bj * 128 + cl) = pack8(acc[ai][bj][m][0] * rs, acc[ai][bj][m][1] * rs); }
    }
};
struct EpiGateUp {
    static constexpr bool PERM = true, AFTER_DRAIN = false;
    bf16* O; const float* ssq;
    __device__ __forceinline__ void operator()(const f4 (&acc)[2][2][4][2], const pg8::Unit& u, int wr, int wc, int fr0, int fq0) const {
        int fr = fr0, fq = fq0; asm volatile("" : "+v"(fr), "+v"(fq));
        const int cl = wc * 32 + 8 * fq, row0 = u.pm * 256 + wr * 64 + fr;
        f4 sq[2][4][2];
#pragma unroll
        for (int ai = 0; ai < 2; ++ai)
#pragma unroll
            for (int m = 0; m < 4; ++m) { const float* p = ssq + (size_t)(row0 + ai * 128 + m * 16) * 8; sq[ai][m][0] = *(const f4*)p; sq[ai][m][1] = *(const f4*)(p + 4); }
        EPI_FENCE();
#pragma unroll
        for (int ai = 0; ai < 2; ++ai)
#pragma unroll
            for (int m = 0; m < 4; ++m) { const int row = row0 + ai * 128 + m * 16; const float rs = rstd_of(sq[ai][m][0], sq[ai][m][1]);
                f4 o0, o1;
#pragma unroll
                for (int e = 0; e < 4; ++e) { const float g0 = acc[ai][0][m][0][e] * rs, g1 = acc[ai][0][m][1][e] * rs;
                    o0[e] = g0 * sigmoidf_(g0) * (acc[ai][1][m][0][e] * rs); o1[e] = g1 * sigmoidf_(g1) * (acc[ai][1][m][1][e] * rs); }
                *(u4*)(O + (size_t)row * DFF + u.pn * 128 + cl) = pack8(o0, o1); }
    }
};
struct DualOrder : pg8::StaticOrder {
    __device__ __forceinline__ bool next(int i, pg8::Unit& u) const { pg8::Unit t; if (!pg8::StaticOrder::next(i >> 1, t)) return false; const int w = i & 1; u.pm = t.pm + 64 * w; u.pn = t.pn + 8 * w; return true; }
};


constexpr int XTRA_OFF = LDSCTL_OFF + 1024;
static_assert(XTRA_OFF + 2048 + 4096 <= LDS_BYTES, "XTRA scratch");
#define OPAQUE_TID() int tid_ = threadIdx.x; asm volatile("" : "+v"(tid_)); const int tid = tid_, lane = tid & 63, wave = __builtin_amdgcn_readfirstlane(tid >> 6), r32 = lane & 31, hi = lane >> 5

__device__ __forceinline__ void swa_phase(LAS unsigned char* L, unsigned char* ws, const float* sinks, int vcu, int G) {
    using namespace mm;
    bf16* QS = (bf16*)(ws + A_QS); const bf16* KS = (const bf16*)(ws + A_KS); const bf16* VS = (const bf16*)(ws + A_VS);
    constexpr int PK = 144, PV = 192;
    LAS unsigned char* Kt = L; LAS unsigned char* Vt = L + 256 * PK;
    for (int un = vcu; un < 512; un += G) {
        OPAQUE_TID();
        LAS float* ssh = (LAS float*)(L + XTRA_OFF) + wave * 32;
        const int trl = tr_lane<PV, true>(lane);
        const int kvh = un & 3, n = un >> 2;
        const long tok0 = (long)n * 128 - 128;
        stage_tile<128, PK, 256>(Kt, KS + tok0 * 256 + kvh * 64, 256, tid, n == 0 ? 128 : 0);
        stage_tile<128, PV, 256>(Vt, VS + tok0 * 256 + kvh * 64, 256, tid, n == 0 ? 128 : 0);
        __syncthreads();
        const int hq = kvh * 4 + (wave >> 1);
        const float sink2 = sinks[hq] * 1.4426950408889634f;
#pragma unroll 1
        for (int sb = 0; sb < 2; ++sb) {
            const int q0 = (wave & 1) * 64 + sb * 32;
            bf16* qrow = QS + ((long)n * 128 + q0 + r32) * 1024 + hq * 64;
            bf16x8 qf[4];
#pragma unroll
            for (int s = 0; s < 4; ++s) qf[s] = *(const bf16x8*)(qrow + 16 * s + 8 * hi);
            f32x16 st[5];
#pragma unroll
            for (int t5 = 0; t5 < 5; ++t5) { f32x16 a = {};
#pragma unroll
                for (int s = 0; s < 4; ++s) a = MFMA32(frag_row<PK>(Kt, q0 + 32 * t5 + r32, 2 * s + hi), qf[s], a);
                st[t5] = a; }
            float mx = sink2;
#pragma unroll
            for (int t5 = 0; t5 < 5; ++t5)
#pragma unroll
                for (int i = 0; i < 16; ++i) { const int kr = crow(i, hi); bool ok = true;
                    if (t5 == 0) ok = kr > r32;
                    if (t5 == 4) ok = kr <= r32;
                    if (n == 0 && q0 + 32 * t5 < 128) ok = false;
                    st[t5][i] = ok ? st[t5][i] : -INFINITY; mx = fmaxf(mx, st[t5][i]); }
            mx = fmaxf(mx, __shfl_xor(mx, 32));
            float sum = 0.f;
#pragma unroll
            for (int t5 = 0; t5 < 5; ++t5)
#pragma unroll
                for (int i = 0; i < 16; ++i) { const float p = __builtin_amdgcn_exp2f(st[t5][i] - mx); st[t5][i] = p; sum += p; }
            sum += __shfl_xor(sum, 32);
            sum += __builtin_amdgcn_exp2f(sink2 - mx);
            f32x16 o[2] = {{}, {}};
#pragma unroll
            for (int t5 = 0; t5 < 5; ++t5)
#pragma unroll
                for (int ks = 0; ks < 2; ++ks) { const bf16x8 pa = pack_step(st[t5], ks);
#pragma unroll
                    for (int db = 0; db < 2; ++db) o[db] = MFMA32(pa, (frag_tr<PV, true>(Vt, trl, q0 + 32 * t5 + 16 * ks, 32 * db)), o[db]); }
            if (hi == 0) ssh[r32] = 1.0f / sum;
            asm volatile("s_waitcnt lgkmcnt(0)" ::: "memory");
#pragma unroll
            for (int i = 0; i < 16; ++i) { const int qr = crow(i, hi); const float rl = ssh[qr];
                bf16* orow = QS + ((long)n * 128 + q0 + qr) * 1024 + hq * 64 + r32;
                orow[0] = f2bf_(o[0][i] * rl); orow[32] = f2bf_(o[1][i] * rl); }
            asm volatile("s_waitcnt lgkmcnt(0)" ::: "memory");
        }
        __syncthreads();
    }
}

__device__ __forceinline__ void xattn_phase(LAS unsigned char* L, unsigned char* ws, int vcu, int G) {
    using namespace mm;
    const bf16* XQ = (const bf16*)(ws + A_XQ); const bf16* KVM = (const bf16*)(ws + WS_KVM); bf16* XA = (bf16*)(ws + A_XA);
    constexpr int PK = 272, PV = 320;
    LAS unsigned char* Kt = L; LAS unsigned char* Vt = L + 256 * PK;
    for (int un = vcu; un < 256; un += G) {
        OPAQUE_TID();
        LAS float* ssh = (LAS float*)(L + XTRA_OFF) + wave * 32;
        const int trl = tr_lane<PV, true>(lane);
        const int hx = un & 3, tg = un >> 2;
        stage_tile<256, PK, 256>(Kt, KVM + hx * 128, 1024, tid);
        stage_tile<256, PV, 256>(Vt, KVM + 512 + hx * 128, 1024, tid);
        __syncthreads();
        const long tokb = (long)tg * 256 + wave * 32;
        const bf16* qrow = XQ + (tokb + r32) * 512 + hx * 128;
        bf16x8 qf[8];
#pragma unroll
        for (int s = 0; s < 8; ++s) qf[s] = *(const bf16x8*)(qrow + 16 * s + 8 * hi);
        f32x16 mt;
#pragma unroll
        for (int i = 0; i < 16; ++i) mt[i] = -INFINITY;
#pragma unroll 1
        for (int kt = 0; kt < 8; ++kt) { f32x16 a = {};
#pragma unroll
            for (int s = 0; s < 8; ++s) a = MFMA32(frag_row<PK>(Kt, 32 * kt + r32, 2 * s + hi), qf[s], a);
#pragma unroll
            for (int i = 0; i < 16; ++i) mt[i] = fmaxf(mt[i], a[i]); }
        float mx = mt[0];
#pragma unroll
        for (int i = 1; i < 16; ++i) mx = fmaxf(mx, mt[i]);
        mx = fmaxf(mx, __shfl_xor(mx, 32));
        f32x16 o[4] = {{}, {}, {}, {}}; float sum = 0.f;
#pragma unroll 1
        for (int kt = 0; kt < 8; ++kt) { f32x16 a = {};
#pragma unroll
            for (int s = 0; s < 8; ++s) a = MFMA32(frag_row<PK>(Kt, 32 * kt + r32, 2 * s + hi), qf[s], a);
#pragma unroll
            for (int i = 0; i < 16; ++i) { a[i] = __builtin_amdgcn_exp2f(a[i] - mx); sum += a[i]; }
#pragma unroll
            for (int ks = 0; ks < 2; ++ks) { const bf16x8 pa = pack_step(a, ks);
#pragma unroll
                for (int db = 0; db < 4; ++db) o[db] = MFMA32(pa, (frag_tr<PV, true>(Vt, trl, 32 * kt + 16 * ks, 32 * db)), o[db]); } }
        sum += __shfl_xor(sum, 32);
        if (hi == 0) ssh[r32] = 1.0f / sum;
        asm volatile("s_waitcnt lgkmcnt(0)" ::: "memory");
#pragma unroll
        for (int i = 0; i < 16; ++i) { const int qr = crow(i, hi); const float rl = ssh[qr];
            bf16* orow = XA + (tokb + qr) * 512 + hx * 128 + r32;
#pragma unroll
            for (int db = 0; db < 4; ++db) orow[32 * db] = f2bf_(o[db][i] * rl); }
        __syncthreads();
    }
}

__device__ __forceinline__ void ret_kv_phase(LAS unsigned char* L, unsigned char* ws, bf16* ST, int vcu, int G) {
    using namespace mm;
    const bf16* KD = (const bf16*)(ws + A_KD); const bf16* VR = (const bf16*)(ws + A_VR);
    constexpr int PT = 576;
    LAS unsigned char* Vt = L; LAS unsigned char* Kt = L + 128 * PT;
    for (int un = vcu; un < 512; un += G) {
        OPAQUE_TID();
        const int trl = tr_lane<PT, false>(lane);
        const int h = un & 3, n = un >> 2;
        stage_tile<512, PT, 128>(Vt, VR + (long)n * 128 * 1024 + h * 256, 1024, tid);
        stage_tile<512, PT, 128>(Kt, KD + (long)n * 128 * 1024 + h * 256, 1024, tid);
        __syncthreads();
        f32x16 acc[8] = {{}, {}, {}, {}, {}, {}, {}, {}};
#pragma unroll 2
        for (int s = 0; s < 8; ++s) { const bf16x8 a = frag_tr<PT, false>(Vt, trl, 16 * s, 32 * wave);
#pragma unroll
            for (int nb = 0; nb < 8; ++nb) acc[nb] = MFMA32(a, (frag_tr<PT, false>(Kt, trl, 16 * s, 32 * nb)), acc[nb]); }
        bf16* dst = ST + ((long)(h * 128 + n) * 256 + 32 * wave) * 256 + r32;
#pragma unroll
        for (int nb = 0; nb < 8; ++nb)
#pragma unroll
            for (int i = 0; i < 16; ++i) dst[(long)crow(i, hi) * 256 + 32 * nb] = f2bf_(acc[nb][i]);
        __syncthreads();
    }
}
__device__ __forceinline__ void ret_scan_phase(bf16* ST, int vcu, int G) {
    const int gt = vcu * (NWAVES * 64) + (int)threadIdx.x;
    for (int el = gt; el < 4 * 32768; el += G * NWAVES * 64) {
        const int h = el >> 15;
        const float decay = exp2f(128.0f * log2_gamma(h));
        unsigned* p = (unsigned*)ST + (long)h * 128 * 32768 + (el & 32767);
        float s0 = 0.f, s1 = 0.f;
#pragma unroll 1
        for (int n0 = 0; n0 < 128; n0 += 16) {
            unsigned kv[16];
#pragma unroll
            for (int j = 0; j < 16; ++j) kv[j] = p[(long)(n0 + j) * 32768];
#pragma unroll
            for (int j = 0; j < 16; ++j) { p[(long)(n0 + j) * 32768] = pk2(s0, s1); s0 = s0 * decay + bflo(kv[j]); s1 = s1 * decay + bfhi(kv[j]); }
        }
    }
}
__device__ __forceinline__ void ret_out_phase(LAS unsigned char* L, unsigned char* ws, const bf16* ST, int vcu, int G) {
    using namespace mm;
    bf16* QR = (bf16*)(ws + A_QR); const bf16* KR = (const bf16*)(ws + A_KR); const bf16* VR = (const bf16*)(ws + A_VR); const bf16* GR = (const bf16*)(ws + A_GR);
    constexpr int PK = 528, PV = 576;
    LAS unsigned char* Kt = L; LAS unsigned char* Vt = L + 128 * PK;
    LAS float* red = (LAS float*)(L + XTRA_OFF + 1024);
    for (int un = vcu; un < 512; un += G) {
        OPAQUE_TID();
        const int trl = tr_lane<PV, true>(lane);
        const int qt = wave >> 1, dh = wave & 1;
        const int h = un & 3, n = un >> 2;
        const float l2g = log2_gamma(h);
        const long t0 = (long)n * 128;
        bf16x8 qf[16];
        { const bf16* qrow = QR + (t0 + 32 * qt + r32) * 1024 + h * 256;
#pragma unroll
            for (int s = 0; s < 16; ++s) qf[s] = *(const bf16x8*)(qrow + 16 * s + 8 * hi); }
        f32x16 o[4] = {{}, {}, {}, {}};
        if (n > 0) {
            stage_tile<512, PK, 256>(L, ST + (long)(h * 128 + n) * 65536, 256, tid);
            __syncthreads();
#pragma unroll
            for (int db = 0; db < 4; ++db)
#pragma unroll
                for (int s = 0; s < 16; ++s) o[db] = MFMA32(qf[s], frag_row<PK>(L, 128 * dh + 32 * db + r32, 2 * s + hi), o[db]);
#pragma unroll
            for (int i = 0; i < 16; ++i) { const float sc = exp2f((float)(32 * qt + crow(i, hi) + 1) * l2g);
#pragma unroll
                for (int db = 0; db < 4; ++db) o[db][i] *= sc; }
            __syncthreads();
        }
        stage_tile<512, PK, 128>(Kt, KR + t0 * 1024 + h * 256, 1024, tid);
        stage_tile<512, PV, 128>(Vt, VR + t0 * 1024 + h * 256, 1024, tid);
        __syncthreads();
#pragma unroll 1
        for (int kt = 0; kt <= qt; ++kt) {
            f32x16 st = {};
#pragma unroll
            for (int s = 0; s < 16; ++s) st = MFMA32(frag_row<PK>(Kt, 32 * kt + r32, 2 * s + hi), qf[s], st);
            const int dq = 32 * (qt - kt) + r32;
#pragma unroll
            for (int i = 0; i < 16; ++i) { const int d = dq - crow(i, hi); st[i] = d >= 0 ? st[i] * exp2f((float)d * l2g) : 0.f; }
#pragma unroll
            for (int ks = 0; ks < 2; ++ks) { const bf16x8 pa = pack_step(st, ks);
#pragma unroll
                for (int db = 0; db < 4; ++db) o[db] = MFMA32(pa, (frag_tr<PV, true>(Vt, trl, 32 * kt + 16 * ks, 128 * dh + 32 * db)), o[db]); }
        }
        float ss[16];
#pragma unroll
        for (int i = 0; i < 16; ++i) { float v = 0.f;
#pragma unroll
            for (int db = 0; db < 4; ++db) v += o[db][i] * o[db][i];
            v += __shfl_xor(v, 1); v += __shfl_xor(v, 2); v += __shfl_xor(v, 4); v += __shfl_xor(v, 8); v += __shfl_xor(v, 16);
            ss[i] = v; }
        if (r32 == 0) {
#pragma unroll
            for (int i = 0; i < 16; ++i) red[wave * 32 + crow(i, hi)] = ss[i]; }
        __syncthreads();
#pragma unroll
        for (int i = 0; i < 16; ++i) { const int qr = crow(i, hi);
            const float tot = red[wave * 32 + qr] + red[(wave ^ 1) * 32 + qr];
            const float rs = 1.0f / sqrtf(tot * (1.f / 256.f) + EPS);
            const long off = (t0 + 32 * qt + qr) * 1024 + h * 256 + 128 * dh + r32;
#pragma unroll
            for (int db = 0; db < 4; ++db) QR[off + 32 * db] = f2bf_(o[db][i] * rs * bf2f(GR[off + 32 * db])); }
        __syncthreads();
    }
}
struct Args { const float* in[19]; const int* pos; float* out; unsigned char* ws; };

#define GRID_BAR() xcd_barrier(bar)
#ifndef REP_MASK
#define REP_MASK 0
#endif
#if REP_MASK
#define REP_BEGIN(k) for (int rep_ = 0; rep_ < 1 + ((REP_MASK >> (k)) & 1); ++rep_) {
#define REP_END }
#else
#define REP_BEGIN(k)
#define REP_END
#endif

__global__ void __launch_bounds__(NWAVES * 64, 2) hybrid_fwd(Args args) {
    extern __shared__ __attribute__((aligned(16))) unsigned char lds[];
    LAS unsigned char* L = (LAS unsigned char*)lds;
    volatile LAS unsigned* MISC = (volatile LAS unsigned*)(L + MISC_OFF);
    const int tid = threadIdx.x, lane = tid & 63, wave = __builtin_amdgcn_readfirstlane(tid >> 6);
    const int G = gridDim.x, bx = blockIdx.x;
    const int vcu = (G % 8 == 0) ? (bx % 8) * (G / 8) + bx / 8 : bx;
    unsigned char* ws = args.ws;
    gu32* ctl = (gu32*)(ws + WS_CTL);
    for (int u = tid; u < (LDS_BYTES - LDSCTL_OFF) / 4; u += NWAVES * 64) ((LAS unsigned*)(L + LDSCTL_OFF))[u] = 0u;
    __syncthreads();
    XcdBarrier bar = xcd_barrier_post((unsigned*)(ctl + CW_BAR), MISC + 8);
    const int gw = vcu * NWAVES + wave, NGW = G * NWAVES;

    const float* x = args.in[0]; const float* mem = args.in[1];
    const float* g_mix = args.in[2]; const float* w_in = args.in[3]; const float* w_up_ret = args.in[4]; const float* w_up_swa = args.in[5];
    const float* sinks = args.in[6]; const float* w_o = args.in[7]; const float* g_x = args.in[8]; const float* g_mem = args.in[9];
    const float* w_xq = args.in[10]; const float* w_xkv = args.in[11]; const float* w_xo = args.in[12]; const float* g_ffn = args.in[13];
    const float* w_gate = args.in[14]; const float* w_up = args.in[15]; const float* w_down = args.in[16]; const float* g_final = args.in[17];
    float* out = args.out;
    bf16* n1 = (bf16*)out;
    bf16* ST = (bf16*)out;

    REP_BEGIN(0)
    {
        LAS float* scr = (LAS float*)(L + RING_OFF + wave * 16384);
        constexpr int I_IN = 32 * 304, I_UR = 16 * 64, I_US = 16 * 64, I_O = 32 * 64, I_XQ = 32 * 16, I_XKV = 32 * 32, I_XO = 8 * 64, I_G = 32 * 176, I_U = 32 * 176, I_DN = 88 * 64;
        constexpr int NITEMS = I_IN + I_UR + I_US + I_O + I_XQ + I_XKV + I_XO + I_G + I_U + I_DN;
        for (int it = gw; it < NITEMS; it += NGW) {
            int r = it;
            if (r < I_IN) { const int nblk = NIN / 32; p0_transpose_item(w_in, D, NIN, (bf16*)(ws + W_IN), r / nblk, r % nblk, 32 * (r % nblk), nullptr, scr, lane); continue; } r -= I_IN;
            if (r < I_UR) { const int nblk = 64; p0_transpose_item(w_up_ret, 1024, D, (bf16*)(ws + W_UR), r / nblk, r % nblk, 32 * (r % nblk), nullptr, scr, lane); continue; } r -= I_UR;
            if (r < I_US) { const int nblk = 64; p0_transpose_item(w_up_swa, 1024, D, (bf16*)(ws + W_US), r / nblk, r % nblk, 32 * (r % nblk), nullptr, scr, lane); continue; } r -= I_US;
            if (r < I_O) { const int nblk = 64; p0_transpose_item(w_o, D, D, (bf16*)(ws + W_O), r / nblk, r % nblk, 32 * (r % nblk), nullptr, scr, lane); continue; } r -= I_O;
            if (r < I_XQ) { const int nblk = 16; p0_transpose_item(w_xq, D, 512, (bf16*)(ws + W_XQ), r / nblk, r % nblk, 32 * (r % nblk), g_x, scr, lane); continue; } r -= I_XQ;
            if (r < I_XKV) { const int nblk = 32; p0_transpose_item(w_xkv, D, 1024, (bf16*)(ws + W_XKV), r / nblk, r % nblk, 32 * (r % nblk), nullptr, scr, lane); continue; } r -= I_XKV;
            if (r < I_XO) { const int nblk = 64; p0_transpose_item(w_xo, 512, D, (bf16*)(ws + W_XO), r / nblk, r % nblk, 32 * (r % nblk), nullptr, scr, lane); continue; } r -= I_XO;
            if (r < I_G) { const int nblk = 176, nb = r % nblk, n0 = 32 * nb; p0_transpose_item(w_gate, D, DFF, (bf16*)(ws + W_GU), r / nblk, nb, (n0 >> 7) * 256 + (n0 & 127), g_ffn, scr, lane); continue; } r -= I_G;
            if (r < I_U) { const int nblk = 176, nb = r % nblk, n0 = 32 * nb; p0_transpose_item(w_up, D, DFF, (bf16*)(ws + W_GU), r / nblk, nb, (n0 >> 7) * 256 + 128 + (n0 & 127), g_ffn, scr, lane); continue; } r -= I_U;
            { const int nblk = 64; p0_transpose_item(w_down, DFF, D, (bf16*)(ws + W_DN), r / nblk, r % nblk, 32 * (r % nblk), nullptr, scr, lane); }
        }
        for (int m = gw; m < M; m += NGW) rms_row_to_bf16(x + (size_t)m * D, g_mix, n1 + (size_t)m * D, lane);
        for (int m = gw; m < NMEM; m += NGW) rms_row_to_bf16(mem + (size_t)m * D, g_mem, (bf16*)(ws + WS_MEMN) + (size_t)m * D, lane);
        const int gt = vcu * (NWAVES * 64) + tid, NGT = G * NWAVES * 64;
        float* cosr = (float*)(ws + WS_COSR); float* sinr = (float*)(ws + WS_SINR); float* coss = (float*)(ws + WS_COSS); float* sins = (float*)(ws + WS_SINS);
        for (int idx = gt; idx < M * 136; idx += NGT) {
            const int t = idx / 136, i = idx % 136;
            const float posf = (float)args.pos[t];
            float inv;
            if (i < 128) inv = (float)exp2(-(double)i * (13.287712379549449 / 128.0));
            else inv = (float)exp2(-(double)(i - 128) * (18.931568569324174 / 8.0));
            const float ang = posf * inv;
            double rev = (double)ang * 0.15915494309189535; rev -= rint(rev);
            const float fr_ = (float)rev;
            const float c = __builtin_amdgcn_cosf(fr_), s = __builtin_amdgcn_sinf(fr_);
            if (i < 128) { cosr[(size_t)t * 128 + i] = c; sinr[(size_t)t * 128 + i] = s; } else { coss[(size_t)t * 8 + (i - 128)] = c; sins[(size_t)t * 8 + (i - 128)] = s; }
        }
    }
    GRID_BAR();
    REP_END

    REP_BEGIN(1)
    {
        pg8::Gemm g{n1, (const bf16*)(ws + W_IN), M, NIN, D}; pg8::StaticOrder S; S.init(M, NIN, G, bx);
        EpiInProj E{ws};
        pg8::gemm_phase<EpiInProj, pg8::StaticOrder, PG8_ALIGN, PG8_SP2>(L + RING_OFF, g, S, E);
        pg8::Gemm g2{(const bf16*)(ws + WS_MEMN), (const bf16*)(ws + W_XKV), NMEM, 1024, D}; pg8::StaticOrder S2; S2.init(NMEM, 1024, G, G - 1 - bx);
        EpiPlain E2{(bf16*)(ws + WS_KVM), 1024};
        pg8::gemm_phase<EpiPlain, pg8::StaticOrder, PG8_ALIGN, PG8_SP2>(L + RING_OFF, g2, S2, E2);
    }
    GRID_BAR();
    REP_END

    REP_BEGIN(2)
    ret_kv_phase(L + RING_OFF, ws, ST, vcu, G);
    REP_END
    swa_phase(L + RING_OFF, ws, sinks, vcu, G);
    GRID_BAR();
    ret_scan_phase(ST, vcu, G);
    GRID_BAR();
    ret_out_phase(L + RING_OFF, ws, ST, vcu, G);
    GRID_BAR();

    REP_BEGIN(3)
    {
        pg8::Gemm g{(const bf16*)(ws + A_QR), (const bf16*)(ws + W_UR), 2 * M, 2 * D, 1024}; DualOrder S; S.init(M, D, G, bx);
        EpiUp E{ws};
        pg8::gemm_phase<EpiUp, DualOrder, PG8_ALIGN, PG8_SP2>(L + RING_OFF, g, S, E);
    }
    GRID_BAR();
    REP_END
    REP_BEGIN(4)
    {
        pg8::Gemm g{(const bf16*)(ws + A_MERGED), (const bf16*)(ws + W_O), M, D, D}; pg8::StaticOrder S; S.init(M, D, G, bx);
        EpiResid E{x, out, (bf16*)(ws + A_H1B), (float*)(ws + WS_SSQ1), (LAS float*)(L + XTRA_OFF + 2048)};
        pg8::gemm_phase<EpiResid, pg8::StaticOrder, PG8_ALIGN, PG8_SP2>(L + RING_OFF, g, S, E);
    }
    GRID_BAR();
    REP_END
    REP_BEGIN(5)
    {
        pg8::Gemm g{(const bf16*)(ws + A_H1B), (const bf16*)(ws + W_XQ), M, 512, D}; pg8::StaticOrder S; S.init(M, 512, G, bx);
        EpiRstd E{(bf16*)(ws + A_XQ), 512, (const float*)(ws + WS_SSQ1), 0.08838834764831845f * 1.4426950408889634f};
        pg8::gemm_phase<EpiRstd, pg8::StaticOrder, PG8_ALIGN, PG8_SP2>(L + RING_OFF, g, S, E);
    }
    GRID_BAR();
    REP_END
    REP_BEGIN(6)
    xattn_phase(L + RING_OFF, ws, vcu, G);
    GRID_BAR();
    REP_END
    {
        pg8::Gemm g{(const bf16*)(ws + A_XA), (const bf16*)(ws + W_XO), M, D, 512}; pg8::StaticOrder S; S.init(M, D, G, bx);
        EpiResid E{out, out, (bf16*)(ws + A_H2B), (float*)(ws + WS_SSQ2), (LAS float*)(L + XTRA_OFF + 2048)};
        pg8::gemm_phase<EpiResid, pg8::StaticOrder, PG8_ALIGN, PG8_SP2>(L + RING_OFF, g, S, E);
    }
    GRID_BAR();
    REP_BEGIN(7)
    {
        pg8::Gemm g{(const bf16*)(ws + A_H2B), (const bf16*)(ws + W_GU), M, 2 * DFF, D}; pg8::StaticOrder S; S.init(M, 2 * DFF, G, bx);
        EpiGateUp E{(bf16*)(ws + A_ACTF), (const float*)(ws + WS_SSQ2)};
        pg8::gemm_phase<EpiGateUp, pg8::StaticOrder, PG8_ALIGN, PG8_SP2>(L + RING_OFF, g, S, E);
    }
    GRID_BAR();
    REP_END
    {
        pg8::Gemm g{(const bf16*)(ws + A_ACTF), (const bf16*)(ws + W_DN), M, D, DFF}; pg8::StaticOrder S; S.init(M, D, G, bx);
        EpiResid E{out, out, nullptr, (float*)(ws + WS_SSQ3), (LAS float*)(L + XTRA_OFF + 2048)};
        pg8::gemm_phase<EpiResid, pg8::StaticOrder, PG8_ALIGN, PG8_SP2>(L + RING_OFF, g, S, E);
    }
    GRID_BAR();
    {
        const float* ssq = (const float*)(ws + WS_SSQ3);
        int t9 = threadIdx.x; asm volatile("" : "+v"(t9)); const int lane = t9 & 63;
        for (int m = gw; m < M; m += NGW) {
            const float rs = rstd_of(*(const f4*)(ssq + (size_t)m * 8), *(const f4*)(ssq + (size_t)m * 8 + 4));
            GAS f4* xr = (GAS f4*)(out + (size_t)m * D) + lane; const GAS f4* gr = (const GAS f4*)g_final + lane;
#pragma unroll
            for (int j = 0; j < 8; ++j) { const f4 v = xr[64 * j], gg = gr[64 * j]; xr[64 * j] = v * rs * gg; }
        }
    }
}

extern "C" void kernel_launch(void* const* d_in, const int* in_sizes, int n_in, void* d_out, int out_size, void* d_ws, size_t ws_size, hipStream_t stream) {
    static int grid = 0;
    if (grid == 0) {
        if (n_in != 19 || in_sizes[0] != M * D || out_size != M * D || ws_size < WS_END) { fprintf(stderr, "kernel_launch: unexpected shapes (n_in %d, in0 %d, out %d, ws %zu); nothing launched\n", n_in, n_in > 0 ? in_sizes[0] : -1, out_size, ws_size); grid = -1; return; }
        int dev = 0, cus = 0, per_cu = 0;
        if (hipGetDevice(&dev) != hipSuccess || hipDeviceGetAttribute(&cus, hipDeviceAttributeMultiprocessorCount, dev) != hipSuccess) { grid = -1; return; }
        if (hipFuncSetAttribute((const void*)hybrid_fwd, hipFuncAttributeMaxDynamicSharedMemorySize, LDS_BYTES) != hipSuccess) { fprintf(stderr, "kernel_launch: hipFuncSetAttribute failed\n"); grid = -1; return; }
        if (hipOccupancyMaxActiveBlocksPerMultiprocessor(&per_cu, (const void*)hybrid_fwd, NWAVES * 64, LDS_BYTES) != hipSuccess || per_cu < 1)
            fprintf(stderr, "kernel_launch: note: occupancy query reports %d workgroups per CU\n", per_cu);
        (void)hipGetLastError();
        grid = cus;
    }
    if (grid < 0) return;
    if (hipMemsetAsync((char*)d_ws + WS_CTL, 0, CTL_ZERO_BYTES, stream) != hipSuccess) { fprintf(stderr, "kernel_launch: hipMemsetAsync failed\n"); return; }
    Args a{};
    a.in[0] = (const float*)d_in[0]; a.in[1] = (const float*)d_in[1]; a.pos = (const int*)d_in[2];
    for (int i = 3; i < 19; ++i) a.in[i - 1] = (const float*)d_in[i];
    a.in[18] = nullptr;
    a.out = (float*)d_out; a.ws = (unsigned char*)d_ws;
    hipLaunchKernelGGL(hybrid_fwd, dim3(grid), dim3(NWAVES * 64), LDS_BYTES, stream, a);
    const hipError_t le = hipPeekAtLastError();
    if (le != hipSuccess) fprintf(stderr, "kernel_launch: launch failed: %s\n", hipGetErrorName(le));
}
```

```cpp
#include <hip/hip_runtime.h>
#include <cstdio>
#include <cstdint>
namespace pg8 {
#define PG8_LAS __attribute__((address_space(3)))
typedef unsigned short bf16_t;
typedef short bf16x8 __attribute__((ext_vector_type(8)));
typedef float f32x4 __attribute__((ext_vector_type(4)));
typedef unsigned u32x4 __attribute__((ext_vector_type(4)));
constexpr int BM = 256, BK = 64, HALF = 128, HTB = HALF * BK * 2  , STAGE_BYTES = 8 * HTB, NXCD = 8, WGM = 8;

__host__ __device__ __forceinline__ int lds_byte(int r, int c) { const int st = (r >> 4) * 2 + (c >> 5), rr = r & 15, cc = c & 31, ob = rr * 64 + cc * 2; return st * 1024 + (ob ^ (((ob >> 9) & 1) << 5)); }
__host__ __device__ __forceinline__ void stage_rc(int b, int& R, int& C) { const int st = b / 1024, sb = b % 1024, swz = sb ^ (((sb >> 9) & 1) << 5); R = (st >> 1) * 16 + swz / 64; C = (st & 1) * 32 + (swz % 64) / 2; }
__host__ __device__ __forceinline__ int perm32(int rho) { const int n = rho >> 4, i = rho & 15; return 8 * (i >> 2) + 4 * n + (i & 3); }

struct Unit { int pm, pn; };
struct Gemm { const bf16_t* A; const bf16_t* Bt; int M, N, K; };

struct StaticOrder {
    int nM, nN, nwg, G, c;
    __host__ __device__ void init(int M, int N, int G_, int c_) { nM = M / BM; nN = N / BM; nwg = nM * nN; G = G_; c = c_; }
    __host__ __device__ bool next(int i, Unit& u) const {
        const long L = (long)i * G + c; if (L >= nwg) return false;
        int wgid = (int)L; { const int q = nwg / NXCD, r = nwg % NXCD, xcd = wgid % NXCD, off = wgid / NXCD; wgid = (xcd < r ? xcd * (q + 1) : r * (q + 1) + (xcd - r) * q) + off; }
        const int nig = WGM * nN, gid = wgid / nig, fm = gid * WGM, gsz = (nM - fm) < WGM ? (nM - fm) : WGM;
        u.pm = fm + ((wgid % nig) % gsz); u.pn = (wgid % nig) / gsz; return true;
    }
    __device__ __forceinline__ void a_ready(const Unit&) const {}
    __device__ __forceinline__ void done(const Unit&) const {}
};

__device__ __forceinline__ unsigned cvt_pk_bf16(float lo, float hi) { unsigned r; asm volatile("v_cvt_pk_bf16_f32 %0, %1, %2" : "=v"(r) : "v"(lo), "v"(hi)); return r; }
typedef float f32x2 __attribute__((ext_vector_type(2)));
template <class Epi, class Sched, bool ALIGN_EPI = false, bool SP2 = false>
__device__ __forceinline__ void gemm_phase(PG8_LAS unsigned char* lds, const Gemm g, const Sched& S, const Epi& E) {
    int tid_ = threadIdx.x; asm volatile("" : "+v"(tid_));
    const int tid = tid_, wid = __builtin_amdgcn_readfirstlane(tid >> 6), lane = tid & 63, wr = wid >> 2, wc = wid & 3, fr = lane & 15, fq = lane >> 4;
    const int K = g.K, nt = K / BK;
    unsigned voffA[2], voffB[2];
#pragma unroll
    for (int i = 0; i < 2; ++i) { int R, C; stage_rc(tid * 16 + i * 8192, R, C); const int Rb = Epi::PERM ? ((R & ~31) + perm32(R & 31)) : R;
        voffA[i] = (unsigned)(R * K + C) * 2u; voffB[i] = (unsigned)(Rb * K + C) * 2u; }
    const size_t kstep = (size_t)(BK * 2);
    const size_t hstep = (size_t)HALF * K * 2;
    const size_t tstep = 2 * hstep;
    const unsigned ldsw = (unsigned)wid * 1024u;
    const int aoff = lds_byte(wr * 64 + fr, fq * 8), boff = lds_byte(wc * 32 + fr, fq * 8);
#define PG8_SA(b, h) (((b) * 2 + (h)) * HTB)
#define PG8_SB(b, h) ((4 + (b) * 2 + (h)) * HTB)
#define PG8_STAGE(bufoff, gbase, voff) do { _Pragma("unroll") for (int _i = 0; _i < 2; ++_i) \
        __builtin_amdgcn_global_load_lds((const unsigned*)((const char*)(gbase) + (voff)[_i]), (PG8_LAS unsigned*)(lds + (bufoff) + ldsw + _i * 8192), 16, 0, 0); } while (0)
#define PG8_LDA(dst, b, h) do { _Pragma("unroll") for (int m = 0; m < 4; ++m) _Pragma("unroll") for (int k = 0; k < 2; ++k) dst[m][k] = *(const PG8_LAS bf16x8*)(lds + PG8_SA(b, h) + aoff + m * 2048 + k * 1024); } while (0)
#define PG8_LDB(dst, b, h) do { _Pragma("unroll") for (int n = 0; n < 2; ++n) _Pragma("unroll") for (int k = 0; k < 2; ++k) dst[n][k] = *(const PG8_LAS bf16x8*)(lds + PG8_SB(b, h) + boff + n * 2048 + k * 1024); } while (0)
#define PG8_MMA(ai, bj, At, Bt) do { __builtin_amdgcn_s_setprio(1); _Pragma("unroll") for (int m = 0; m < 4; ++m) _Pragma("unroll") for (int n = 0; n < 2; ++n) _Pragma("unroll") for (int k = 0; k < 2; ++k) \
        acc[ai][bj][m][n] = __builtin_amdgcn_mfma_f32_16x16x32_bf16(Bt[n][k], At[m][k], acc[ai][bj][m][n], 0, 0, 0); __builtin_amdgcn_s_setprio(0); } while (0)
#define PG8_WAIT_V(n) asm volatile("s_waitcnt vmcnt(" #n ")" ::: "memory")
#define PG8_WAIT_L(n) asm volatile("s_waitcnt lgkmcnt(" #n ")" ::: "memory")
#define PG8_BAR __builtin_amdgcn_s_barrier()
#define PG8_SCHED __builtin_amdgcn_sched_barrier(0)
    Unit cur, nxt; int ui = 0;
    if (!S.next(0, cur)) return;
    f32x4 acc[2][2][4][2];
#pragma unroll
    for (int a = 0; a < 2; ++a)
#pragma unroll
        for (int b = 0; b < 2; ++b)
#pragma unroll
            for (int m = 0; m < 4; ++m)
#pragma unroll
                for (int n = 0; n < 2; ++n) acc[a][b][m][n] = (f32x4){0.f, 0.f, 0.f, 0.f};
    bf16x8 At[4][2], B0[2][2], B1[2][2];
    const char* cA = (const char*)g.A + (size_t)cur.pm * tstep; const char* cB = (const char*)g.Bt + (size_t)cur.pn * tstep;
    S.a_ready(cur);
    if constexpr (SP2) {
        PG8_STAGE(PG8_SB(0, 0), cB, voffB); PG8_STAGE(PG8_SB(0, 1), cB + hstep, voffB); PG8_STAGE(PG8_SA(0, 0), cA, voffA); PG8_STAGE(PG8_SA(0, 1), cA + hstep, voffA);
        if (wr == 1) PG8_BAR;
        PG8_WAIT_V(2); PG8_BAR;
        PG8_STAGE(PG8_SB(1, 0), cB + kstep, voffB); PG8_STAGE(PG8_SA(1, 0), cA + kstep, voffA); PG8_STAGE(PG8_SB(1, 1), cB + hstep + kstep, voffB);
        PG8_WAIT_V(6); PG8_BAR;
    } else {
        PG8_STAGE(PG8_SB(0, 0), cB, voffB); PG8_STAGE(PG8_SA(0, 0), cA, voffA); PG8_STAGE(PG8_SB(0, 1), cB + hstep, voffB); PG8_STAGE(PG8_SA(0, 1), cA + hstep, voffA);
        if (wr == 1) PG8_BAR;
        PG8_WAIT_V(4); PG8_BAR;
        PG8_STAGE(PG8_SB(1, 0), cB + kstep, voffB); PG8_STAGE(PG8_SA(1, 0), cA + kstep, voffA); PG8_STAGE(PG8_SB(1, 1), cB + hstep + kstep, voffB);
        PG8_WAIT_V(6); PG8_BAR;
    }
    for (;;) {
        const bool has_next = S.next(ui + 1, nxt);
        const char* nA = has_next ? (const char*)g.A + (size_t)nxt.pm * tstep : cA; const char* nB = has_next ? (const char*)g.Bt + (size_t)nxt.pn * tstep : cB;
        for (int t = 0; t < nt; t += 2) {
            const bool last = (t == nt - 2);
            const char* a1 = cA + (size_t)(t + 1) * kstep;
            const char* a2 = last ? nA : cA + (size_t)(t + 2) * kstep; const char* b2 = last ? nB : cB + (size_t)(t + 2) * kstep;
            const char* a3 = a2 + kstep; const char* b3 = b2 + kstep;
            if (last && has_next) S.a_ready(nxt);
            if constexpr (SP2) {
            PG8_LDB(B0, 0, 0); PG8_LDB(B1, 0, 1); PG8_SCHED; PG8_LDA(At, 0, 0); PG8_STAGE(PG8_SA(1, 1), a1 + hstep, voffA);
            PG8_WAIT_V(8); PG8_WAIT_L(0); PG8_BAR; PG8_MMA(0, 0, At, B0); PG8_MMA(0, 1, At, B1); PG8_BAR; PG8_SCHED;
            PG8_LDA(At, 0, 1); PG8_STAGE(PG8_SB(0, 0), b2, voffB); PG8_STAGE(PG8_SB(0, 1), b2 + hstep, voffB); PG8_STAGE(PG8_SA(0, 0), a2, voffA);
            PG8_WAIT_V(8); PG8_WAIT_L(0); PG8_BAR; PG8_MMA(1, 0, At, B0); PG8_MMA(1, 1, At, B1); PG8_BAR; PG8_SCHED;
            PG8_LDB(B0, 1, 0); PG8_LDB(B1, 1, 1); PG8_SCHED; PG8_LDA(At, 1, 0); PG8_STAGE(PG8_SA(0, 1), a2 + hstep, voffA);
            PG8_WAIT_V(8); PG8_WAIT_L(0); PG8_BAR; PG8_MMA(0, 0, At, B0); PG8_MMA(0, 1, At, B1); PG8_BAR; PG8_SCHED;
            PG8_LDA(At, 1, 1); PG8_STAGE(PG8_SB(1, 0), b3, voffB); PG8_STAGE(PG8_SB(1, 1), b3 + hstep, voffB); PG8_STAGE(PG8_SA(1, 0), a3, voffA);
            PG8_WAIT_V(8); PG8_WAIT_L(0); PG8_BAR; PG8_MMA(1, 0, At, B0); PG8_MMA(1, 1, At, B1); PG8_BAR; PG8_SCHED;
            } else {
            PG8_LDB(B0, 0, 0); PG8_SCHED; PG8_LDA(At, 0, 0); PG8_STAGE(PG8_SA(1, 1), a1 + hstep, voffA);
            PG8_WAIT_L(8); PG8_BAR; PG8_WAIT_L(0); PG8_MMA(0, 0, At, B0); PG8_BAR; PG8_SCHED;
            PG8_LDB(B1, 0, 1); PG8_STAGE(PG8_SB(0, 0), b2, voffB);
            PG8_BAR; PG8_WAIT_L(0); PG8_MMA(0, 1, At, B1); PG8_BAR;
            PG8_LDA(At, 0, 1); PG8_STAGE(PG8_SA(0, 0), a2, voffA);
            PG8_BAR; PG8_WAIT_L(0); PG8_MMA(1, 0, At, B0); PG8_BAR; PG8_SCHED;
            PG8_STAGE(PG8_SB(0, 1), b2 + hstep, voffB);
            PG8_WAIT_V(6); PG8_BAR; PG8_MMA(1, 1, At, B1); PG8_BAR;
            PG8_LDB(B0, 1, 0); PG8_SCHED; PG8_LDA(At, 1, 0); PG8_STAGE(PG8_SA(0, 1), a2 + hstep, voffA);
            PG8_WAIT_L(8); PG8_BAR; PG8_WAIT_L(0); PG8_MMA(0, 0, At, B0); PG8_BAR; PG8_SCHED;
            PG8_LDB(B1, 1, 1); PG8_STAGE(PG8_SB(1, 0), b3, voffB);
            PG8_BAR; PG8_WAIT_L(0); PG8_MMA(0, 1, At, B1); PG8_BAR;
            PG8_LDA(At, 1, 1); PG8_STAGE(PG8_SA(1, 0), a3, voffA);
            PG8_BAR; PG8_WAIT_L(0); PG8_MMA(1, 0, At, B0); PG8_BAR; PG8_SCHED;
            PG8_STAGE(PG8_SB(1, 1), b3 + hstep, voffB);
            PG8_WAIT_V(6); PG8_BAR; PG8_MMA(1, 1, At, B1); PG8_BAR;
            }
        }
        if constexpr (ALIGN_EPI) { if (wr == 0) PG8_BAR; }
        if constexpr (!Epi::AFTER_DRAIN) { E(acc, cur, wr, wc, fr, fq); S.done(cur); }
        if (!has_next) break;
#pragma unroll
        for (int a = 0; a < 2; ++a)
#pragma unroll
            for (int b = 0; b < 2; ++b)
#pragma unroll
                for (int m = 0; m < 4; ++m)
#pragma unroll
                    for (int n = 0; n < 2; ++n) acc[a][b][m][n] = (f32x4){0.f, 0.f, 0.f, 0.f};
        cur = nxt; cA = nA; cB = nB; ++ui;
        if constexpr (ALIGN_EPI) { if (wr == 1) PG8_BAR; }
    }
    PG8_WAIT_V(0);
    if constexpr (!ALIGN_EPI) { if (wr == 0) PG8_BAR; }
    PG8_BAR;
    if constexpr (Epi::AFTER_DRAIN) { E.fused(acc, cur, wr, wc, fr, fq, lds, wid, lane); S.done(cur); }
#undef PG8_SA
#undef PG8_SB
#undef PG8_STAGE
#undef PG8_LDA
#undef PG8_LDB
#undef PG8_MMA
#undef PG8_WAIT_V
#undef PG8_WAIT_L
#undef PG8_BAR
#undef PG8_SCHED
}
}

#ifndef PG8_SP2
#define PG8_SP2 true
#endif
#ifndef PG8_ALIGN
#define PG8_ALIGN true
#endif
#define GAS __attribute__((address_space(1)))
#define LAS __attribute__((address_space(3)))
typedef unsigned short bf16;
typedef unsigned v4u __attribute__((ext_vector_type(4)));
typedef float f32x4 __attribute__((ext_vector_type(4)));
typedef short bf16x8 __attribute__((ext_vector_type(8)));
typedef GAS unsigned gu32;
typedef GAS unsigned long long gu64;
#define RLX_AGENT __ATOMIC_RELAXED, __HIP_MEMORY_SCOPE_AGENT
#define LDS_WAIT() asm volatile("s_waitcnt lgkmcnt(0)" ::: "memory")
#define VM_WAIT() asm volatile("s_waitcnt vmcnt(0)" ::: "memory")
__device__ __forceinline__ unsigned long long rt() { return __builtin_amdgcn_s_memrealtime(); }
__device__ __forceinline__ unsigned f2bf(float f) { unsigned u = __builtin_bit_cast(unsigned, f); return (u + 0x7fffu + ((u >> 16) & 1u)) >> 16; }
__device__ __forceinline__ unsigned pk2(float lo, float hi) { return f2bf(lo) | (f2bf(hi) << 16); }

#define XB_TMO      128
#define XB_XCNT(j)  (256  + 64 * (j))
#define XB_XSUB(j)  (1280 + 64 * (j))
#define XB_XGEN(j)  (2304 + 64 * (j))
#define XB_TOP      3328
#define XB_TOPGEN   3392
#define XCD_BAR_WORDS 3456
#define XB_SPIN_CAP (1u << 22)

__device__ __forceinline__ unsigned xb_ld(unsigned* p)              { return __hip_atomic_load(p, __ATOMIC_RELAXED, __HIP_MEMORY_SCOPE_AGENT); }
__device__ __forceinline__ unsigned xb_add(unsigned* p, unsigned v) { return __hip_atomic_fetch_add(p, v, __ATOMIC_RELAXED, __HIP_MEMORY_SCOPE_AGENT); }
__device__ __forceinline__ unsigned xb_xcc_id() { return (unsigned)__builtin_amdgcn_s_getreg((3 << 11) | 20) & 0xFu; }
#define XB_SPIN(cond, bar) do { unsigned _sp = 0; while (cond) { __builtin_amdgcn_s_sleep(1); \
    if ((++_sp & 255u) == 0u) { if (xb_ld(&(bar)[XB_TMO])) break; if (_sp > XB_SPIN_CAP) { atomicAdd(&(bar)[XB_TMO], 1u); break; } } } } while (0)

struct XcdBarrier {
    unsigned* bar; unsigned x;
    volatile LAS unsigned* st;
};

__device__ __forceinline__ XcdBarrier xcd_barrier_post(unsigned* bar, volatile LAS unsigned* st) {
    XcdBarrier b; b.bar = bar; b.x = xb_xcc_id(); b.st = st;
    if (threadIdx.x == 0) (void)xb_add(&bar[XB_XCNT(b.x)], 1u);
    return b;
}
__device__ __forceinline__ void xcd_barrier_complete(unsigned* bar, unsigned x, unsigned& nloc, unsigned& nx) {
    const unsigned G = gridDim.x * gridDim.y * gridDim.z;
    unsigned sum, cnt, mine, sp = 0u;
    for (;;) {
        sum = 0u; cnt = 0u; mine = 0u;
#pragma unroll
        for (unsigned j = 0; j < 16; ++j) { const unsigned c = xb_ld(&bar[XB_XCNT(j)]); sum += c; cnt += (c > 0u) ? 1u : 0u; mine = (j == x) ? c : mine; }
        if (sum == G) break;
        __builtin_amdgcn_s_sleep(1);
        if ((++sp & 255u) == 0u) { if (xb_ld(&bar[XB_TMO])) break; if (sp > XB_SPIN_CAP) { atomicAdd(&bar[XB_TMO], 1u); break; } }
    }
    nloc = mine > 0u ? mine : 1u; nx = cnt > 0u ? cnt : 1u;
}

__device__ __forceinline__ void xcd_barrier(const XcdBarrier& b) {
    asm volatile("s_waitcnt vmcnt(0)" ::: "memory");
    __syncthreads();
    if (threadIdx.x == 0) {
        unsigned* bar = b.bar;
        __builtin_amdgcn_s_waitcnt(0);
        unsigned nloc = b.st[0], nx = b.st[1];
        if (nloc == 0u) { xcd_barrier_complete(bar, b.x, nloc, nx); b.st[0] = nloc; b.st[1] = nx; }
        const unsigned old = xb_add(&bar[XB_XSUB(b.x)], 1u);
        const unsigned gen = old / nloc;
        if (old + 1u == (gen + 1u) * nloc) {
            __builtin_amdgcn_fence(__ATOMIC_RELEASE, "agent");
            asm volatile("s_waitcnt vmcnt(0)" ::: "memory");
            const unsigned og = xb_add(&bar[XB_TOP], 1u);
            const unsigned tg = og / nx;
            if (og + 1u == (tg + 1u) * nx) xb_add(&bar[XB_TOPGEN], 1u);
            else XB_SPIN(xb_ld(&bar[XB_TOPGEN]) == tg, bar);
            __builtin_amdgcn_fence(__ATOMIC_ACQUIRE, "agent");
            xb_add(&bar[XB_XGEN(b.x)], 1u);
            asm volatile("s_waitcnt vmcnt(0)" ::: "memory");
        } else {
            XB_SPIN(xb_ld(&bar[XB_XGEN(b.x)]) == gen, bar);
            __builtin_amdgcn_fence(__ATOMIC_ACQUIRE, "agent");
            asm volatile("s_waitcnt vmcnt(0)" ::: "memory");
        }
    }
    __syncthreads();
}

namespace mm {
typedef short bf16x8 __attribute__((ext_vector_type(8)));
typedef short s16x4 __attribute__((ext_vector_type(4)));
typedef float f32x16 __attribute__((ext_vector_type(16)));
typedef unsigned u32x4 __attribute__((ext_vector_type(4)));
#define MM_LAS __attribute__((address_space(3)))
#define MFMA32(a, b, c) __builtin_amdgcn_mfma_f32_32x32x16_bf16((a), (b), (c), 0, 0, 0)
__device__ __forceinline__ int crow(int i, int h) { return (i & 3) + 8 * (i >> 2) + 4 * h; }
template <int ROWB, int PITCH, int NROWS> __device__ __forceinline__ void stage_tile(MM_LAS unsigned char* dst, const unsigned short* src, long ld, int tid, int zero_below = 0) {
    constexpr int CPR = ROWB / 16, TOT = NROWS * CPR, PER = TOT / 512, B = PER > 8 ? 8 : PER;
    static_assert(TOT % 512 == 0 && PER % B == 0 && PITCH % 16 == 0, "stage_tile shape");
#pragma unroll
    for (int b0 = 0; b0 < PER; b0 += B) {
        u32x4 v[B];
#pragma unroll
        for (int c = 0; c < B; ++c) { const int id = tid + 512 * (b0 + c), row = id / CPR, ch = id % CPR;
            const int rl = row < zero_below ? zero_below : row;
            v[c] = *(const u32x4*)(src + (long)rl * ld + ch * 8);
            if (row < zero_below) v[c] = (u32x4){0u, 0u, 0u, 0u}; }
#pragma unroll
        for (int c = 0; c < B; ++c) { const int id = tid + 512 * (b0 + c), row = id / CPR, ch = id % CPR;
            *(MM_LAS u32x4*)(dst + row * PITCH + 16 * ch) = v[c]; }
    }
}
template <int PITCH> __device__ __forceinline__ bf16x8 frag_row(const MM_LAS unsigned char* t, int row, int kchunk) { return *(const MM_LAS bf16x8*)(t + row * PITCH + 16 * kchunk); }
__device__ __forceinline__ s16x4 vtr(const MM_LAS unsigned char* p) { typedef short v4i16_t __attribute__((ext_vector_type(4))); return __builtin_bit_cast(s16x4, __builtin_amdgcn_ds_read_tr16_b64_v4i16((MM_LAS v4i16_t*)p)); }
template <int PITCH, bool PERM> __device__ __forceinline__ int tr_lane(int lane) {
    const int g1 = (lane >> 4) & 1, h = lane >> 5, q = (lane >> 2) & 3, p = lane & 3;
    return ((PERM ? 4 * h : 8 * h) + q) * PITCH + 2 * (16 * g1 + 4 * p);
}
template <int PITCH, bool PERM> __device__ __forceinline__ bf16x8 frag_tr(const MM_LAS unsigned char* t, int trl, int kbase, int nbase) {
    const MM_LAS unsigned char* p = t + trl + kbase * PITCH + 2 * nbase;
    const s16x4 lo = vtr(p), hi = vtr(p + (PERM ? 8 : 4) * PITCH);
    return (bf16x8){lo[0], lo[1], lo[2], lo[3], hi[0], hi[1], hi[2], hi[3]};
}
__device__ __forceinline__ unsigned cvtpk(float lo, float hi) { typedef float f2_t __attribute__((ext_vector_type(2))); typedef __bf16 b2_t __attribute__((ext_vector_type(2))); f2_t v = {lo, hi}; b2_t b = __builtin_convertvector(v, b2_t); return __builtin_bit_cast(unsigned, b); }
__device__ __forceinline__ bf16x8 pack_step(const f32x16& x, int s) {
    u32x4 p; p.x = cvtpk(x[8 * s], x[8 * s + 1]); p.y = cvtpk(x[8 * s + 2], x[8 * s + 3]); p.z = cvtpk(x[8 * s + 4], x[8 * s + 5]); p.w = cvtpk(x[8 * s + 6], x[8 * s + 7]);
    return __builtin_bit_cast(bf16x8, p);
}
__device__ __forceinline__ unsigned short f2bf_(float f) { return (unsigned short)(cvtpk(f, 0.f) & 0xffffu); }
}

constexpr int NWAVES = 8;
constexpr int M = 16384, D = 2048, NIN = 9728, DFF = 5632, NMEM = 256;
constexpr float EPS = 1e-6f;
constexpr size_t MiB = 1u << 20;
constexpr size_t WS_CTL = 0, CTL_ZERO_BYTES = 1 * MiB;
constexpr size_t WS_SSQ1 = 1 * MiB, WS_SSQ2 = 3 * MiB, WS_SSQ3 = 5 * MiB;
constexpr size_t WS_MEMN = 7 * MiB;
constexpr size_t WS_KVM = 8 * MiB;
constexpr size_t WS_COSS = 9 * MiB, WS_SINS = 9 * MiB + 512 * 1024;
constexpr size_t WS_COSR = 10 * MiB, WS_SINR = 18 * MiB;
constexpr size_t WS_W = 26 * MiB;
constexpr size_t W_IN = WS_W, W_UR = WS_W + 38 * MiB, W_US = WS_W + 42 * MiB, W_O = WS_W + 46 * MiB, W_XQ = WS_W + 54 * MiB,
                 W_XKV = WS_W + 56 * MiB, W_XO = WS_W + 60 * MiB, W_GU = WS_W + 62 * MiB, W_DN = WS_W + 106 * MiB;
constexpr size_t WS_ACT = 154 * MiB;
constexpr size_t A_QR = WS_ACT + 0 * MiB, A_QS = WS_ACT + 32 * MiB, A_KR = WS_ACT + 64 * MiB, A_KD = WS_ACT + 96 * MiB, A_VR = WS_ACT + 128 * MiB,
                 A_GR = WS_ACT + 160 * MiB, A_KS = WS_ACT + 192 * MiB, A_VS = WS_ACT + 200 * MiB, A_SGR = WS_ACT + 208 * MiB, A_SGS = WS_ACT + 272 * MiB;
constexpr size_t A_MERGED = WS_ACT + 64 * MiB, A_H1B = WS_ACT + 128 * MiB, A_XQ = WS_ACT + 0 * MiB, A_XA = WS_ACT + 16 * MiB, A_H2B = WS_ACT + 64 * MiB,
                 A_ACTF = WS_ACT + 160 * MiB;
constexpr size_t WS_END = 490 * MiB;
static_assert(A_ACTF + (size_t)M * DFF * 2 <= WS_END && WS_END <= 512 * MiB, "d_ws map");
constexpr int CW_BAR = 4096;
constexpr int RING_OFF = 0, RING_BYTES = 131072;
constexpr int LDSCTL_OFF = 155648, MISC_OFF = LDSCTL_OFF + 320;
constexpr int LDS_BYTES = 163840;

typedef pg8::f32x4 f4;
typedef unsigned u4 __attribute__((ext_vector_type(4)));
typedef unsigned u2 __attribute__((ext_vector_type(2)));
__device__ __forceinline__ float bf2f(unsigned short b) { return __uint_as_float((unsigned)b << 16); }
__device__ __forceinline__ float bflo(unsigned w) { return __uint_as_float(w << 16); }
__device__ __forceinline__ float bfhi(unsigned w) { return __uint_as_float(w & 0xffff0000u); }
__device__ __forceinline__ float wave_sum(float v) {
#pragma unroll
    for (int o = 1; o < 64; o <<= 1) v += __shfl_xor(v, o);
    return v;
}
__device__ __forceinline__ float wave_max(float v) {
#pragma unroll
    for (int o = 1; o < 64; o <<= 1) v = fmaxf(v, __shfl_xor(v, o));
    return v;
}
__device__ __forceinline__ float sigmoidf_(float v) { return __builtin_amdgcn_rcpf(1.0f + __builtin_amdgcn_exp2f(v * -1.4426950408889634f)); }
__device__ __forceinline__ u4 pack8(const f4& a, const f4& b) {
    u4 w; w.x = pg8::cvt_pk_bf16(a[0], a[1]); w.y = pg8::cvt_pk_bf16(a[2], a[3]); w.z = pg8::cvt_pk_bf16(b[0], b[1]); w.w = pg8::cvt_pk_bf16(b[2], b[3]); return w;
}
__device__ __forceinline__ float log2_gamma(int h) {
    return h == 0 ? -0.045803689613124704f : h == 1 ? -0.022720076500083645f : h == 2 ? -0.011315313227834157f : -0.005646563141142062f;
}

__device__ __forceinline__ void p0_transpose_item(const float* W, int K, int N, bf16* WT, int kb, int nb, int drow0, const float* gk, LAS float* scr, int lane) {
    const int k0 = 64 * kb, n0 = 32 * nb, r8 = lane >> 3, c4 = (lane & 7) * 4;
    f4 w[8]; float g[8];
#pragma unroll
    for (int i = 0; i < 8; ++i) { w[i] = *(const GAS f4*)(W + (size_t)(k0 + r8 + 8 * i) * N + n0 + c4); g[i] = gk ? gk[k0 + r8 + 8 * i] : 1.0f; }
#pragma unroll
    for (int i = 0; i < 8; ++i) { LAS float* d = scr + (r8 + 8 * i) * 33 + c4; d[0] = w[i].x * g[i]; d[1] = w[i].y * g[i]; d[2] = w[i].z * g[i]; d[3] = w[i].w * g[i]; }
    LDS_WAIT(); asm volatile("" ::: "memory");
    const int c = lane & 7;
#pragma unroll
    for (int j = 0; j < 4; ++j) { const int n = (lane >> 3) + 8 * j; const LAS float* s = scr + (8 * c) * 33 + n;
        v4u o; o.x = pk2(s[0 * 33], s[1 * 33]); o.y = pk2(s[2 * 33], s[3 * 33]); o.z = pk2(s[4 * 33], s[5 * 33]); o.w = pk2(s[6 * 33], s[7 * 33]);
        *(GAS v4u*)(WT + (size_t)(drow0 + n) * K + k0 + 8 * c) = o; }
    LDS_WAIT(); asm volatile("" ::: "memory");
}
__device__ __forceinline__ void rms_row_to_bf16(const float* xrow, const float* g, bf16* orow, int lane) {
    const GAS f4* xr = (const GAS f4*)xrow + lane; const GAS f4* gr = (const GAS f4*)g + lane;
    f4 v[8]; float s = 0.f;
#pragma unroll
    for (int j = 0; j < 8; ++j) { v[j] = xr[64 * j]; s += (v[j].x * v[j].x + v[j].y * v[j].y) + (v[j].z * v[j].z + v[j].w * v[j].w); }
    const float rstd = __builtin_amdgcn_rsqf(wave_sum(s) * (1.f / 2048.f) + EPS);
    GAS unsigned long long* o8 = (GAS unsigned long long*)orow + lane;
#pragma unroll
    for (int j = 0; j < 8; ++j) { const f4 gg = gr[64 * j]; o8[64 * j] = (unsigned long long)pk2(v[j].x * rstd * gg.x, v[j].y * rstd * gg.y) | ((unsigned long long)pk2(v[j].z * rstd * gg.z, v[j].w * rstd * gg.w) << 32); }
}

#define EPI_FENCE() asm volatile("" ::: "memory")
struct EpiInProj {
    static constexpr bool PERM = true, AFTER_DRAIN = false;
    unsigned char* ws;
    __device__ __forceinline__ void operator()(const f4 (&acc)[2][2][4][2], const pg8::Unit& u, int wr, int wc, int fr0, int fq0) const {
        int fr = fr0, fq = fq0; asm volatile("" : "+v"(fr), "+v"(fq));
        const int pn = u.pn, cl = wc * 32 + 8 * fq, row0 = u.pm * 256 + wr * 64 + fr;
        const float* cosr = (const float*)(ws + WS_COSR); const float* sinr = (const float*)(ws + WS_SINR);
        const float* coss = (const float*)(ws + WS_COSS); const float* sins = (const float*)(ws + WS_SINS);
        if (pn < 8) {
            const bool isk = pn >= 4; const int hh = pn & 3;
            bf16* dst = (bf16*)(ws + (isk ? A_KR : A_QR)); bf16* dkd = (bf16*)(ws + A_KD);
            const float l2g = log2_gamma(hh);
#pragma unroll
            for (int aim = 0; aim < 4; ++aim) {
                const int ai = aim >> 1;
                f4 cs[2][4];
#pragma unroll
                for (int mm = 0; mm < 2; ++mm) { const int m = (aim & 1) * 2 + mm; const size_t to = (size_t)(row0 + ai * 128 + m * 16) * 128 + cl;
                    cs[mm][0] = *(const f4*)(cosr + to); cs[mm][1] = *(const f4*)(cosr + to + 4); cs[mm][2] = *(const f4*)(sinr + to); cs[mm][3] = *(const f4*)(sinr + to + 4); }
                EPI_FENCE();
#pragma unroll
                for (int mm = 0; mm < 2; ++mm) { const int m = (aim & 1) * 2 + mm; const int row = row0 + ai * 128 + m * 16;
                    const f4 c0 = cs[mm][0], c1 = cs[mm][1], s0 = cs[mm][2], s1 = cs[mm][3];
                    const f4 a0 = acc[ai][0][m][0], a1 = acc[ai][0][m][1], b0 = acc[ai][1][m][0], b1 = acc[ai][1][m][1];
                    f4 y0 = a0 * c0 - b0 * s0, y1 = a1 * c1 - b1 * s1, z0 = b0 * c0 + a0 * s0, z1 = b1 * c1 + a1 * s1;
                    if (isk) { y0 = y0 * 0.0625f; y1 = y1 * 0.0625f; z0 = z0 * 0.0625f; z1 = z1 * 0.0625f; }
                    bf16* p = dst + (size_t)row * 1024 + hh * 256 + cl;
                    *(u4*)p = pack8(y0, y1); *(u4*)(p + 128) = pack8(z0, z1);
                    if (isk) { const float dec = __builtin_amdgcn_exp2f((float)(127 - (row & 127)) * l2g);
                        bf16* q = dkd + (size_t)row * 1024 + hh * 256 + cl;
                        *(u4*)q = pack8(y0 * dec, y1 * dec); *(u4*)(q + 128) = pack8(z0 * dec, z1 * dec); } }
                EPI_FENCE();
            }
        } else if (pn < 16 || pn >= 21) {
            bf16* dst; int ld, colb, mode;
            if (pn < 12) { dst = (bf16*)(ws + A_VR); ld = 1024; colb = (pn - 8) * 256; mode = 0; }
            else if (pn < 16) { dst = (bf16*)(ws + A_GR); ld = 1024; colb = (pn - 12) * 256; mode = 1; }
            else if (pn == 21) { dst = (bf16*)(ws + A_VS); ld = 256; colb = 0; mode = 0; }
            else if (pn < 30) { dst = (bf16*)(ws + A_SGR); ld = 2048; colb = (pn - 22) * 256; mode = 2; }
            else { dst = (bf16*)(ws + A_SGS); ld = 2048; colb = (pn - 30) * 256; mode = 2; }
#pragma unroll
            for (int ai = 0; ai < 2; ++ai)
#pragma unroll
                for (int m = 0; m < 4; ++m) { const int row = row0 + ai * 128 + m * 16;
#pragma unroll
                    for (int bj = 0; bj < 2; ++bj) { f4 v0 = acc[ai][bj][m][0], v1 = acc[ai][bj][m][1];
                        if (mode != 0) {
#pragma unroll
                            for (int e = 0; e < 4; ++e) { const float g0 = sigmoidf_(v0[e]), g1 = sigmoidf_(v1[e]); v0[e] = mode == 1 ? v0[e] * g0 : g0; v1[e] = mode == 1 ? v1[e] * g1 : g1; } }
                        *(u4*)(dst + (size_t)row * ld + colb + bj * 128 + cl) = pack8(v0, v1); } }
        } else {
            const bool isq = pn < 20;
            bf16* dst = (bf16*)(ws + (isq ? A_QS : A_KS)); const int ld = isq ? 1024 : 256, colb = isq ? (pn - 16) * 256 : 0;
            const int hc = cl & 63;
            const float sc = isq ? 0.125f * 1.4426950408889634f : 1.0f;
            const float fc = (hc < 16) ? 1.f : 0.f, fs = (hc == 0) ? -1.f : (hc == 8) ? 1.f : 0.f;
#pragma unroll
            for (int ai = 0; ai < 2; ++ai) {
                f4 cs[4][4];
#pragma unroll
                for (int m = 0; m < 4; ++m) { const size_t to = (size_t)(row0 + ai * 128 + m * 16) * 8;
                    cs[m][0] = *(const f4*)(coss + to); cs[m][1] = *(const f4*)(coss + to + 4); cs[m][2] = *(const f4*)(sins + to); cs[m][3] = *(const f4*)(sins + to + 4); }
                EPI_FENCE();
#pragma unroll
                for (int m = 0; m < 4; ++m) { const int row = row0 + ai * 128 + m * 16;
                    const f4 c0 = cs[m][0], c1 = cs[m][1], s0 = cs[m][2], s1 = cs[m][3];
#pragma unroll
                    for (int bj = 0; bj < 2; ++bj) { f4 v0 = acc[ai][bj][m][0], v1 = acc[ai][bj][m][1]; f4 p0, p1;
#pragma unroll
                        for (int e = 0; e < 4; ++e) { p0[e] = __shfl_xor(v0[e], 16); p1[e] = __shfl_xor(v1[e], 16); }
                        v0 = v0 * ((c0 - 1.f) * fc + 1.f) + p0 * (s0 * fs); v1 = v1 * ((c1 - 1.f) * fc + 1.f) + p1 * (s1 * fs);
                        v0 = v0 * sc; v1 = v1 * sc;
                        *(u4*)(dst + (size_t)row * ld + colb + bj * 128 + cl) = pack8(v0, v1); } }
                EPI_FENCE();
            }
        }
    }
};
struct EpiPlain {
    static constexpr bool PERM = true, AFTER_DRAIN = false;
    bf16* O; int ldc;
    __device__ __forceinline__ void operator()(const f4 (&acc)[2][2][4][2], const pg8::Unit& u, int wr, int wc, int fr0, int fq0) const {
        int fr = fr0, fq = fq0; asm volatile("" : "+v"(fr), "+v"(fq));
        const int cl = wc * 32 + 8 * fq, row0 = u.pm * 256 + wr * 64 + fr;
#pragma unroll
        for (int ai = 0; ai < 2; ++ai)
#pragma unroll
            for (int m = 0; m < 4; ++m) { const int row = row0 + ai * 128 + m * 16;
#pragma unroll
                for (int bj = 0; bj < 2; ++bj) *(u4*)(O + (size_t)row * ldc + u.pn * 256 + bj * 128 + cl) = pack8(acc[ai][bj][m][0], acc[ai][bj][m][1]); }
    }
};
struct EpiUp {
    static constexpr bool PERM = true, AFTER_DRAIN = false;
    unsigned char* ws;
    __device__ __forceinline__ void operator()(const f4 (&acc)[2][2][4][2], const pg8::Unit& u, int wr, int wc, int fr0, int fq0) const {
        int fr = fr0, fq = fq0; asm volatile("" : "+v"(fr), "+v"(fq));
        const int w = u.pm >= 64 ? 1 : 0, pm = u.pm & 63, pn = u.pn & 7;
        const int cl = wc * 32 + 8 * fq, row0 = pm * 256 + wr * 64 + fr;
        const bf16* gate = (const bf16*)(ws + (w ? A_SGS : A_SGR)); bf16* mg = (bf16*)(ws + A_MERGED);
#pragma unroll
        for (int ai = 0; ai < 2; ++ai) {
            u4 g[4][2], p[4][2];
#pragma unroll
            for (int m = 0; m < 4; ++m)
#pragma unroll
                for (int bj = 0; bj < 2; ++bj) { const size_t off = (size_t)(row0 + ai * 128 + m * 16) * 2048 + pn * 256 + bj * 128 + cl;
                    g[m][bj] = *(const u4*)(gate + off); p[m][bj] = w ? *(const u4*)(mg + off) : (u4){0u, 0u, 0u, 0u}; }
            EPI_FENCE();
#pragma unroll
            for (int m = 0; m < 4; ++m)
#pragma unroll
                for (int bj = 0; bj < 2; ++bj) { const size_t off = (size_t)(row0 + ai * 128 + m * 16) * 2048 + pn * 256 + bj * 128 + cl;
                    const u4 gg = g[m][bj], pp = p[m][bj]; f4 v0 = acc[ai][bj][m][0], v1 = acc[ai][bj][m][1];
                    v0[0] = v0[0] * bflo(gg.x) + bflo(pp.x); v0[1] = v0[1] * bfhi(gg.x) + bfhi(pp.x); v0[2] = v0[2] * bflo(gg.y) + bflo(pp.y); v0[3] = v0[3] * bfhi(gg.y) + bfhi(pp.y);
                    v1[0] = v1[0] * bflo(gg.z) + bflo(pp.z); v1[1] = v1[1] * bfhi(gg.z) + bfhi(pp.z); v1[2] = v1[2] * bflo(gg.w) + bflo(pp.w); v1[3] = v1[3] * bfhi(gg.w) + bfhi(pp.w);
                    *(u4*)(mg + off) = pack8(v0, v1); }
            EPI_FENCE();
        }
    }
};
struct EpiResid {
    static constexpr bool PERM = true, AFTER_DRAIN = false;
    const float* base; float* out; bf16* hb; float* ssq; LAS float* xss;
    __device__ __forceinline__ void operator()(const f4 (&acc)[2][2][4][2], const pg8::Unit& u, int wr, int wc, int fr0, int fq0) const {
        int fr = fr0, fq = fq0; asm volatile("" : "+v"(fr), "+v"(fq));
        const int cl = wc * 32 + 8 * fq, row0 = u.pm * 256 + wr * 64 + fr;
        float ss[2][4];
#pragma unroll
        for (int ai = 0; ai < 2; ++ai) {
            f4 xr[4][2][2];
#pragma unroll
            for (int m = 0; m < 4; ++m)
#pragma unroll
                for (int bj = 0; bj < 2; ++bj) { const size_t off = (size_t)(row0 + ai * 128 + m * 16) * 2048 + u.pn * 256 + bj * 128 + cl;
                    xr[m][bj][0] = *(const f4*)(base + off); xr[m][bj][1] = *(const f4*)(base + off + 4); }
            EPI_FENCE();
#pragma unroll
            for (int m = 0; m < 4; ++m) { float s = 0.f;
#pragma unroll
                for (int bj = 0; bj < 2; ++bj) { const size_t off = (size_t)(row0 + ai * 128 + m * 16) * 2048 + u.pn * 256 + bj * 128 + cl;
                    const f4 h0 = xr[m][bj][0] + acc[ai][bj][m][0], h1 = xr[m][bj][1] + acc[ai][bj][m][1];
                    *(f4*)(out + off) = h0; *(f4*)(out + off + 4) = h1;
                    if (hb) *(u4*)(hb + off) = pack8(h0, h1);
                    s += (h0[0] * h0[0] + h0[1] * h0[1]) + (h0[2] * h0[2] + h0[3] * h0[3]) + (h1[0] * h1[0] + h1[1] * h1[1]) + (h1[2] * h1[2] + h1[3] * h1[3]); }
                s += __shfl_xor(s, 16); s += __shfl_xor(s, 32); ss[ai][m] = s; }
            EPI_FENCE();
        }
        if (fq == 0) {
#pragma unroll
            for (int ai = 0; ai < 2; ++ai)
#pragma unroll
                for (int m = 0; m < 4; ++m) xss[wc * 256 + ai * 128 + wr * 64 + m * 16 + fr] = ss[ai][m]; }
        asm volatile("s_waitcnt lgkmcnt(0)" ::: "memory"); __builtin_amdgcn_s_barrier(); asm volatile("" ::: "memory");
        const int t = (wr * 4 + wc) * 64 + fq * 16 + fr;
        if (t < 256) ssq[(size_t)(u.pm * 256 + t) * 8 + u.pn] = (xss[t] + xss[256 + t]) + (xss[512 + t] + xss[768 + t]);
    }
};
__device__ __forceinline__ float rstd_of(const f4& a, const f4& b) { return __builtin_amdgcn_rsqf(((a[0] + a[1]) + (a[2] + a[3]) + (b[0] + b[1]) + (b[2] + b[3])) * (1.f / 2048.f) + EPS); }
struct EpiRstd {
    static constexpr bool PERM = true, AFTER_DRAIN = false;
    bf16* O; int ldc; const float* ssq; float scale;
    __device__ __forceinline__ void operator()(const f4 (&acc)[2][2][4][2], const pg8::Unit& u, int wr, int wc, int fr0, int fq0) const {
        int fr = fr0, fq = fq0; asm volatile("" : "+v"(fr), "+v"(fq));
        const int cl = wc * 32 + 8 * fq, row0 = u.pm * 256 + wr * 64 + fr;
        f4 sq[2][4][2];
#pragma unroll
        for (int ai = 0; ai < 2; ++ai)
#pragma unroll
            for (int m = 0; m < 4; ++m) { const float* p = ssq + (size_t)(row0 + ai * 128 + m * 16) * 8; sq[ai][m][0] = *(const f4*)p; sq[ai][m][1] = *(const f4*)(p + 4); }
        EPI_FENCE();
#pragma unroll
        for (int ai = 0; ai < 2; ++ai)
#pragma unroll
            for (int m = 0; m < 4; ++m) { const int row = row0 + ai * 128 + m * 16; const float rs = rstd_of(sq[ai][m][0], sq[ai][m][1]) * scale;
#pragma unroll
                for (int bj = 0; bj < 2; ++bj) *(u4*)(O + (size_t)row * ldc + u.pn * 256 + bj * 128 + cl) = pack8(acc[ai][bj][m][0] * rs, acc[ai][bj][m][1] * rs); }
    }
};
struct EpiGateUp {
    static constexpr bool PERM = true, AFTER_DRAIN = false;
    bf16* O; const float* ssq;
    __device__ __forceinline__ void operator()(const f4 (&acc)[2][2][4][2], const pg8::Unit& u, int wr, int wc, int fr0, int fq0) const {
        int fr = fr0, fq = fq0; asm volatile("" : "+v"(fr), "+v"(fq));
        const int cl = wc * 32 + 8 * fq, row0 = u.pm * 256 + wr * 64 + fr;
        f4 sq[2][4][2];
#pragma unroll
        for (int ai = 0; ai < 2; ++ai)
#pragma unroll
            for (int m = 0; m < 4; ++m) { const float* p = ssq + (size_t)(row0 + ai * 128 + m * 16) * 8; sq[ai][m][0] = *(const f4*)p; sq[ai][m][1] = *(const f4*)(p + 4); }
        EPI_FENCE();
#pragma unroll
        for (int ai = 0; ai < 2; ++ai)
#pragma unroll
            for (int m = 0; m < 4; ++m) { const int row = row0 + ai * 128 + m * 16; const float rs = rstd_of(sq[ai][m][0], sq[ai][m][1]);
                f4 o0, o1;
#pragma unroll
                for (int e = 0; e < 4; ++e) { const float g0 = acc[ai][0][m][0][e] * rs, g1 = acc[ai][0][m][1][e] * rs;
                    o0[e] = g0 * sigmoidf_(g0) * (acc[ai][1][m][0][e] * rs); o1[e] = g1 * sigmoidf_(g1) * (acc[ai][1][m][1][e] * rs); }
                *(u4*)(O + (size_t)row * DFF + u.pn * 128 + cl) = pack8(o0, o1); }
    }
};
struct EpiHalfPlain {
    static constexpr bool PERM = true, AFTER_DRAIN = false;
    bf16* O;
    __device__ __forceinline__ void operator()(const f4 (&acc)[2][2][4][2], const pg8::Unit& u, int wr, int wc, int fr, int fq) const {
        const int cl = wc * 32 + 8 * fq, row0 = u.pm * 256 + wr * 64 + fr;
#pragma unroll
        for (int ai = 0; ai < 2; ++ai)
#pragma unroll
            for (int m = 0; m < 4; ++m) *(u4*)(O + (size_t)(row0 + ai * 128 + m * 16) * DFF + u.pn * 128 + cl) = pack8(acc[ai][0][m][0] + acc[ai][1][m][0], acc[ai][0][m][1] + acc[ai][1][m][1]);
    }
};
struct DualOrder : pg8::StaticOrder {
    __device__ __forceinline__ bool next(int i, pg8::Unit& u) const { pg8::Unit t; if (!pg8::StaticOrder::next(i >> 1, t)) return false; const int w = i & 1; u.pm = t.pm + 64 * w; u.pn = t.pn + 8 * w; return true; }
};


constexpr int XTRA_OFF = LDSCTL_OFF + 1024;
static_assert(XTRA_OFF + 2048 + 4096 <= LDS_BYTES, "XTRA scratch");
#define OPAQUE_TID() int tid_ = threadIdx.x; asm volatile("" : "+v"(tid_)); const int tid = tid_, lane = tid & 63, wave = __builtin_amdgcn_readfirstlane(tid >> 6), r32 = lane & 31, hi = lane >> 5

__device__ __forceinline__ void swa_phase(LAS unsigned char* L, unsigned char* ws, const float* sinks, int vcu, int G) {
    using namespace mm;
    bf16* QS = (bf16*)(ws + A_QS); const bf16* KS = (const bf16*)(ws + A_KS); const bf16* VS = (const bf16*)(ws + A_VS);
    constexpr int PK = 144, PV = 192;
    LAS unsigned char* Kt = L; LAS unsigned char* Vt = L + 256 * PK;
    for (int un = vcu; un < 512; un += G) {
        OPAQUE_TID();
        LAS float* ssh = (LAS float*)(L + XTRA_OFF) + wave * 32;
        const int trl = tr_lane<PV, true>(lane);
        const int kvh = un & 3, n = un >> 2;
        const long tok0 = (long)n * 128 - 128;
        stage_tile<128, PK, 256>(Kt, KS + tok0 * 256 + kvh * 64, 256, tid, n == 0 ? 128 : 0);
        stage_tile<128, PV, 256>(Vt, VS + tok0 * 256 + kvh * 64, 256, tid, n == 0 ? 128 : 0);
        __syncthreads();
        const int hq = kvh * 4 + (wave >> 1);
        const float sink2 = sinks[hq] * 1.4426950408889634f;
#pragma unroll 1
        for (int sb = 0; sb < 2; ++sb) {
            const int q0 = (wave & 1) * 64 + sb * 32;
            bf16* qrow = QS + ((long)n * 128 + q0 + r32) * 1024 + hq * 64;
            bf16x8 qf[4];
#pragma unroll
            for (int s = 0; s < 4; ++s) qf[s] = *(const bf16x8*)(qrow + 16 * s + 8 * hi);
            f32x16 st[5];
#pragma unroll
            for (int t5 = 0; t5 < 5; ++t5) { f32x16 a = {};
#pragma unroll
                for (int s = 0; s < 4; ++s) a = MFMA32(frag_row<PK>(Kt, q0 + 32 * t5 + r32, 2 * s + hi), qf[s], a);
                st[t5] = a; }
            float mx = sink2;
#pragma unroll
            for (int t5 = 0; t5 < 5; ++t5)
#pragma unroll
                for (int i = 0; i < 16; ++i) { const int kr = crow(i, hi); bool ok = true;
                    if (t5 == 0) ok = kr > r32;
                    if (t5 == 4) ok = kr <= r32;
                    if (n == 0 && q0 + 32 * t5 < 128) ok = false;
                    st[t5][i] = ok ? st[t5][i] : -INFINITY; mx = fmaxf(mx, st[t5][i]); }
            mx = fmaxf(mx, __shfl_xor(mx, 32));
            float sum = 0.f;
#pragma unroll
            for (int t5 = 0; t5 < 5; ++t5)
#pragma unroll
                for (int i = 0; i < 16; ++i) { const float p = __builtin_amdgcn_exp2f(st[t5][i] - mx); st[t5][i] = p; sum += p; }
            sum += __shfl_xor(sum, 32);
            sum += __builtin_amdgcn_exp2f(sink2 - mx);
            f32x16 o[2] = {{}, {}};
#pragma unroll
            for (int t5 = 0; t5 < 5; ++t5)
#pragma unroll
                for (int ks = 0; ks < 2; ++ks) { const bf16x8 pa = pack_step(st[t5], ks);
#pragma unroll
                    for (int db = 0; db < 2; ++db) o[db] = MFMA32(pa, (frag_tr<PV, true>(Vt, trl, q0 + 32 * t5 + 16 * ks, 32 * db)), o[db]); }
            if (hi == 0) ssh[r32] = __builtin_amdgcn_rcpf(sum);
            asm volatile("s_waitcnt lgkmcnt(0)" ::: "memory");
#pragma unroll
            for (int i = 0; i < 16; ++i) { const int qr = crow(i, hi); const float rl = ssh[qr];
                bf16* orow = QS + ((long)n * 128 + q0 + qr) * 1024 + hq * 64 + r32;
                orow[0] = f2bf_(o[0][i] * rl); orow[32] = f2bf_(o[1][i] * rl); }
            asm volatile("s_waitcnt lgkmcnt(0)" ::: "memory");
        }
        __syncthreads();
    }
}

__device__ __forceinline__ void xattn_phase(LAS unsigned char* L, unsigned char* ws, int vcu, int G) {
    using namespace mm;
    const bf16* XQ = (const bf16*)(ws + A_XQ); const bf16* KVM = (const bf16*)(ws + WS_KVM); bf16* XA = (bf16*)(ws + A_XA);
    constexpr int PK = 272, PV = 320;
    LAS unsigned char* Kt = L; LAS unsigned char* Vt = L + 256 * PK;
    for (int un = vcu; un < 256; un += G) {
        OPAQUE_TID();
        LAS float* ssh = (LAS float*)(L + XTRA_OFF) + wave * 32;
        const int trl = tr_lane<PV, true>(lane);
        const int hx = un & 3, tg = un >> 2;
        stage_tile<256, PK, 256>(Kt, KVM + hx * 128, 1024, tid);
        stage_tile<256, PV, 256>(Vt, KVM + 512 + hx * 128, 1024, tid);
        __syncthreads();
        const long tokb = (long)tg * 256 + wave * 32;
        const bf16* qrow = XQ + (tokb + r32) * 512 + hx * 128;
        bf16x8 qf[8];
#pragma unroll
        for (int s = 0; s < 8; ++s) qf[s] = *(const bf16x8*)(qrow + 16 * s + 8 * hi);
        f32x16 mt;
#pragma unroll
        for (int i = 0; i < 16; ++i) mt[i] = -INFINITY;
#pragma unroll 1
        for (int kt = 0; kt < 8; ++kt) { f32x16 a = {};
#pragma unroll
            for (int s = 0; s < 8; ++s) a = MFMA32(frag_row<PK>(Kt, 32 * kt + r32, 2 * s + hi), qf[s], a);
#pragma unroll
            for (int i = 0; i < 16; ++i) mt[i] = fmaxf(mt[i], a[i]); }
        float mx = mt[0];
#pragma unroll
        for (int i = 1; i < 16; ++i) mx = fmaxf(mx, mt[i]);
        mx = fmaxf(mx, __shfl_xor(mx, 32));
        f32x16 o[4] = {{}, {}, {}, {}}; float sum = 0.f;
#pragma unroll 1
        for (int kt = 0; kt < 8; ++kt) { f32x16 a = {};
#pragma unroll
            for (int s = 0; s < 8; ++s) a = MFMA32(frag_row<PK>(Kt, 32 * kt + r32, 2 * s + hi), qf[s], a);
#pragma unroll
            for (int i = 0; i < 16; ++i) { a[i] = __builtin_amdgcn_exp2f(a[i] - mx); sum += a[i]; }
#pragma unroll
            for (int ks = 0; ks < 2; ++ks) { const bf16x8 pa = pack_step(a, ks);
#pragma unroll
                for (int db = 0; db < 4; ++db) o[db] = MFMA32(pa, (frag_tr<PV, true>(Vt, trl, 32 * kt + 16 * ks, 32 * db)), o[db]); } }
        sum += __shfl_xor(sum, 32);
        if (hi == 0) ssh[r32] = __builtin_amdgcn_rcpf(sum);
        asm volatile("s_waitcnt lgkmcnt(0)" ::: "memory");
#pragma unroll
        for (int i = 0; i < 16; ++i) { const int qr = crow(i, hi); const float rl = ssh[qr];
            bf16* orow = XA + (tokb + qr) * 512 + hx * 128 + r32;
#pragma unroll
            for (int db = 0; db < 4; ++db) orow[32 * db] = f2bf_(o[db][i] * rl); }
        __syncthreads();
    }
}

__device__ __forceinline__ void ret_kv_phase(LAS unsigned char* L, unsigned char* ws, bf16* ST, int vcu, int G) {
    using namespace mm;
    const bf16* KD = (const bf16*)(ws + A_KD); const bf16* VR = (const bf16*)(ws + A_VR);
    constexpr int PT = 576;
    LAS unsigned char* Vt = L; LAS unsigned char* Kt = L + 128 * PT;
    for (int un = vcu; un < 512; un += G) {
        OPAQUE_TID();
        const int trl = tr_lane<PT, false>(lane);
        const int h = un & 3, n = un >> 2;
        stage_tile<512, PT, 128>(Vt, VR + (long)n * 128 * 1024 + h * 256, 1024, tid);
        stage_tile<512, PT, 128>(Kt, KD + (long)n * 128 * 1024 + h * 256, 1024, tid);
        __syncthreads();
        f32x16 acc[8] = {{}, {}, {}, {}, {}, {}, {}, {}};
#pragma unroll 2
        for (int s = 0; s < 8; ++s) { const bf16x8 a = frag_tr<PT, false>(Vt, trl, 16 * s, 32 * wave);
#pragma unroll
            for (int nb = 0; nb < 8; ++nb) acc[nb] = MFMA32(a, (frag_tr<PT, false>(Kt, trl, 16 * s, 32 * nb)), acc[nb]); }
        bf16* dst = ST + ((long)(h * 128 + n) * 256 + 32 * wave) * 256 + r32;
#pragma unroll
        for (int nb = 0; nb < 8; ++nb)
#pragma unroll
            for (int i = 0; i < 16; ++i) dst[(long)crow(i, hi) * 256 + 32 * nb] = f2bf_(acc[nb][i]);
        __syncthreads();
    }
}
__device__ __forceinline__ void ret_scan_phase(bf16* ST, int vcu, int G) {
    const int gt = vcu * (NWAVES * 64) + (int)threadIdx.x;
    for (int el = gt; el < 4 * 32768; el += G * NWAVES * 64) {
        const int h = el >> 15;
        const float decay = exp2f(128.0f * log2_gamma(h));
        unsigned* p = (unsigned*)ST + (long)h * 128 * 32768 + (el & 32767);
        float s0 = 0.f, s1 = 0.f;
#pragma unroll 1
        for (int n0 = 0; n0 < 128; n0 += 16) {
            unsigned kv[16];
#pragma unroll
            for (int j = 0; j < 16; ++j) kv[j] = p[(long)(n0 + j) * 32768];
#pragma unroll
            for (int j = 0; j < 16; ++j) { p[(long)(n0 + j) * 32768] = pk2(s0, s1); s0 = s0 * decay + bflo(kv[j]); s1 = s1 * decay + bfhi(kv[j]); }
        }
    }
}
__device__ __forceinline__ void ret_out_phase(LAS unsigned char* L, unsigned char* ws, const bf16* ST, int vcu, int G) {
    using namespace mm;
    bf16* QR = (bf16*)(ws + A_QR); const bf16* KR = (const bf16*)(ws + A_KR); const bf16* VR = (const bf16*)(ws + A_VR); const bf16* GR = (const bf16*)(ws + A_GR);
    constexpr int PK = 528, PV = 576;
    LAS unsigned char* Kt = L; LAS unsigned char* Vt = L + 128 * PK;
    LAS float* red = (LAS float*)(L + XTRA_OFF + 1024);
    for (int un = vcu; un < 512; un += G) {
        OPAQUE_TID();
        const int trl = tr_lane<PV, true>(lane);
        const int qt = wave >> 1, dh = wave & 1;
        const int h = un & 3, n = un >> 2;
        const float l2g = log2_gamma(h);
        const long t0 = (long)n * 128;
        bf16x8 qf[16];
        { const bf16* qrow = QR + (t0 + 32 * qt + r32) * 1024 + h * 256;
#pragma unroll
            for (int s = 0; s < 16; ++s) qf[s] = *(const bf16x8*)(qrow + 16 * s + 8 * hi); }
        f32x16 o[4] = {{}, {}, {}, {}};
        if (n > 0) {
            stage_tile<512, PK, 256>(L, ST + (long)(h * 128 + n) * 65536, 256, tid);
            __syncthreads();
#pragma unroll
            for (int db = 0; db < 4; ++db)
#pragma unroll
                for (int s = 0; s < 16; ++s) o[db] = MFMA32(qf[s], frag_row<PK>(L, 128 * dh + 32 * db + r32, 2 * s + hi), o[db]);
#pragma unroll
            for (int i = 0; i < 16; ++i) { const float sc = __builtin_amdgcn_exp2f((float)(32 * qt + crow(i, hi) + 1) * l2g);
#pragma unroll
                for (int db = 0; db < 4; ++db) o[db][i] *= sc; }
            __syncthreads();
        }
        stage_tile<512, PK, 128>(Kt, KR + t0 * 1024 + h * 256, 1024, tid);
        stage_tile<512, PV, 128>(Vt, VR + t0 * 1024 + h * 256, 1024, tid);
        __syncthreads();
#pragma unroll 1
        for (int kt = 0; kt <= qt; ++kt) {
            f32x16 st = {};
#pragma unroll
            for (int s = 0; s < 16; ++s) st = MFMA32(frag_row<PK>(Kt, 32 * kt + r32, 2 * s + hi), qf[s], st);
            const int dq = 32 * (qt - kt) + r32;
#pragma unroll
            for (int i = 0; i < 16; ++i) { const int d = dq - crow(i, hi); st[i] = d >= 0 ? st[i] * __builtin_amdgcn_exp2f((float)d * l2g) : 0.f; }
#pragma unroll
            for (int ks = 0; ks < 2; ++ks) { const bf16x8 pa = pack_step(st, ks);
#pragma unroll
                for (int db = 0; db < 4; ++db) o[db] = MFMA32(pa, (frag_tr<PV, true>(Vt, trl, 32 * kt + 16 * ks, 128 * dh + 32 * db)), o[db]); }
        }
        float ss[16];
#pragma unroll
        for (int i = 0; i < 16; ++i) { float v = 0.f;
#pragma unroll
            for (int db = 0; db < 4; ++db) v += o[db][i] * o[db][i];
            v += __shfl_xor(v, 1); v += __shfl_xor(v, 2); v += __shfl_xor(v, 4); v += __shfl_xor(v, 8); v += __shfl_xor(v, 16);
            ss[i] = v; }
        if (r32 == 0) {
#pragma unroll
            for (int i = 0; i < 16; ++i) red[wave * 32 + crow(i, hi)] = ss[i]; }
        __syncthreads();
#pragma unroll
        for (int i = 0; i < 16; ++i) { const int qr = crow(i, hi);
            const float tot = red[wave * 32 + qr] + red[(wave ^ 1) * 32 + qr];
            const float rs = __builtin_amdgcn_rsqf(tot * (1.f / 256.f) + EPS);
            const long off = (t0 + 32 * qt + qr) * 1024 + h * 256 + 128 * dh + r32;
#pragma unroll
            for (int db = 0; db < 4; ++db) QR[off + 32 * db] = f2bf_(o[db][i] * rs * bf2f(GR[off + 32 * db])); }
        __syncthreads();
    }
}
struct Args { const float* in[19]; const int* pos; float* out; unsigned char* ws; };

#define GRID_BAR() xcd_barrier(bar)
#ifndef REP_MASK
#define REP_MASK 0
#endif
#if REP_MASK
#define REP_BEGIN(k) for (int rep_ = 0; rep_ < 1 + ((REP_MASK >> (k)) & 1); ++rep_) {
#define REP_END }
#else
#define REP_BEGIN(k)
#define REP_END
#endif

__global__ void __launch_bounds__(NWAVES * 64, 2) hybrid_fwd(Args args) {
    extern __shared__ __attribute__((aligned(16))) unsigned char lds[];
    LAS unsigned char* L = (LAS unsigned char*)lds;
    volatile LAS unsigned* MISC = (volatile LAS unsigned*)(L + MISC_OFF);
    const int tid = threadIdx.x, lane = tid & 63, wave = __builtin_amdgcn_readfirstlane(tid >> 6);
    const int G = gridDim.x, bx = blockIdx.x;
    const int vcu = (G % 8 == 0) ? (bx % 8) * (G / 8) + bx / 8 : bx;
    unsigned char* ws = args.ws;
    gu32* ctl = (gu32*)(ws + WS_CTL);
    for (int u = tid; u < (LDS_BYTES - LDSCTL_OFF) / 4; u += NWAVES * 64) ((LAS unsigned*)(L + LDSCTL_OFF))[u] = 0u;
    __syncthreads();
    XcdBarrier bar = xcd_barrier_post((unsigned*)(ctl + CW_BAR), MISC + 8);
    const int gw = vcu * NWAVES + wave, NGW = G * NWAVES;

    const float* x = args.in[0]; const float* mem = args.in[1];
    const float* g_mix = args.in[2]; const float* w_in = args.in[3]; const float* w_up_ret = args.in[4]; const float* w_up_swa = args.in[5];
    const float* sinks = args.in[6]; const float* w_o = args.in[7]; const float* g_x = args.in[8]; const float* g_mem = args.in[9];
    const float* w_xq = args.in[10]; const float* w_xkv = args.in[11]; const float* w_xo = args.in[12]; const float* g_ffn = args.in[13];
    const float* w_gate = args.in[14]; const float* w_up = args.in[15]; const float* w_down = args.in[16]; const float* g_final = args.in[17];
    float* out = args.out;
    bf16* n1 = (bf16*)out;
    bf16* ST = (bf16*)out;

    REP_BEGIN(0)
    {
        LAS float* scr = (LAS float*)(L + RING_OFF + wave * 16384);
        constexpr int I_IN = 32 * 304, I_UR = 16 * 64, I_US = 16 * 64, I_O = 32 * 64, I_XQ = 32 * 16, I_XKV = 32 * 32, I_XO = 8 * 64, I_G = 32 * 176, I_U = 32 * 176, I_DN = 88 * 64;
        constexpr int NITEMS = I_IN + I_UR + I_US + I_O + I_XQ + I_XKV + I_XO + I_G + I_U + I_DN;
        for (int it = gw; it < NITEMS; it += NGW) {
            int r = it;
            if (r < I_IN) { const int nblk = NIN / 32; p0_transpose_item(w_in, D, NIN, (bf16*)(ws + W_IN), r / nblk, r % nblk, 32 * (r % nblk), nullptr, scr, lane); continue; } r -= I_IN;
            if (r < I_UR) { const int nblk = 64; p0_transpose_item(w_up_ret, 1024, D, (bf16*)(ws + W_UR), r / nblk, r % nblk, 32 * (r % nblk), nullptr, scr, lane); continue; } r -= I_UR;
            if (r < I_US) { const int nblk = 64; p0_transpose_item(w_up_swa, 1024, D, (bf16*)(ws + W_US), r / nblk, r % nblk, 32 * (r % nblk), nullptr, scr, lane); continue; } r -= I_US;
            if (r < I_O) { const int nblk = 64; p0_transpose_item(w_o, D, D, (bf16*)(ws + W_O), r / nblk, r % nblk, 32 * (r % nblk), nullptr, scr, lane); continue; } r -= I_O;
            if (r < I_XQ) { const int nblk = 16; p0_transpose_item(w_xq, D, 512, (bf16*)(ws + W_XQ), r / nblk, r % nblk, 32 * (r % nblk), g_x, scr, lane); continue; } r -= I_XQ;
            if (r < I_XKV) { const int nblk = 32; p0_transpose_item(w_xkv, D, 1024, (bf16*)(ws + W_XKV), r / nblk, r % nblk, 32 * (r % nblk), nullptr, scr, lane); continue; } r -= I_XKV;
            if (r < I_XO) { const int nblk = 64; p0_transpose_item(w_xo, 512, D, (bf16*)(ws + W_XO), r / nblk, r % nblk, 32 * (r % nblk), nullptr, scr, lane); continue; } r -= I_XO;
            if (r < I_G) { const int nblk = 176, nb = r % nblk, n0 = 32 * nb; p0_transpose_item(w_gate, D, DFF, (bf16*)(ws + W_GU), r / nblk, nb, (n0 >> 7) * 256 + (n0 & 127), g_ffn, scr, lane); continue; } r -= I_G;
            if (r < I_U) { const int nblk = 176, nb = r % nblk, n0 = 32 * nb; p0_transpose_item(w_up, D, DFF, (bf16*)(ws + W_GU), r / nblk, nb, (n0 >> 7) * 256 + 128 + (n0 & 127), g_ffn, scr, lane); continue; } r -= I_U;
            { const int nblk = 64; p0_transpose_item(w_down, DFF, D, (bf16*)(ws + W_DN), r / nblk, r % nblk, 32 * (r % nblk), nullptr, scr, lane); }
        }
        for (int m = gw; m < M; m += NGW) rms_row_to_bf16(x + (size_t)m * D, g_mix, n1 + (size_t)m * D, lane);
        for (int m = gw; m < NMEM; m += NGW) rms_row_to_bf16(mem + (size_t)m * D, g_mem, (bf16*)(ws + WS_MEMN) + (size_t)m * D, lane);
        const int gt = vcu * (NWAVES * 64) + tid, NGT = G * NWAVES * 64;
        float* cosr = (float*)(ws + WS_COSR); float* sinr = (float*)(ws + WS_SINR); float* coss = (float*)(ws + WS_COSS); float* sins = (float*)(ws + WS_SINS);
        for (int idx = gt; idx < M * 136; idx += NGT) {
            const int t = idx / 136, i = idx % 136;
            const float posf = (float)args.pos[t];
            float inv;
            if (i < 128) inv = (float)exp2(-(double)i * (13.287712379549449 / 128.0));
            else inv = (float)exp2(-(double)(i - 128) * (18.931568569324174 / 8.0));
            const float ang = posf * inv;
            double rev = (double)ang * 0.15915494309189535; rev -= rint(rev);
            const float fr_ = (float)rev;
            const float c = __builtin_amdgcn_cosf(fr_), s = __builtin_amdgcn_sinf(fr_);
            if (i < 128) { cosr[(size_t)t * 128 + i] = c; sinr[(size_t)t * 128 + i] = s; } else { coss[(size_t)t * 8 + (i - 128)] = c; sins[(size_t)t * 8 + (i - 128)] = s; }
        }
    }
    GRID_BAR();
    REP_END

    REP_BEGIN(1)
    {
        pg8::Gemm g{n1, (const bf16*)(ws + W_IN), M, NIN, D}; pg8::StaticOrder S; S.init(M, NIN, G, bx);
        EpiInProj E{ws};
        pg8::gemm_phase<EpiInProj, pg8::StaticOrder, PG8_ALIGN, PG8_SP2>(L + RING_OFF, g, S, E);
        pg8::Gemm g2{(const bf16*)(ws + WS_MEMN), (const bf16*)(ws + W_XKV), NMEM, 1024, D}; pg8::StaticOrder S2; S2.init(NMEM, 1024, G, G - 1 - bx);
        EpiPlain E2{(bf16*)(ws + WS_KVM), 1024};
        pg8::gemm_phase<EpiPlain, pg8::StaticOrder, PG8_ALIGN, PG8_SP2>(L + RING_OFF, g2, S2, E2);
    }
    GRID_BAR();
    REP_END

    REP_BEGIN(2)
    ret_kv_phase(L + RING_OFF, ws, ST, vcu, G);
    REP_END
    swa_phase(L + RING_OFF, ws, sinks, vcu, G);
    GRID_BAR();
    ret_scan_phase(ST, vcu, G);
    GRID_BAR();
    ret_out_phase(L + RING_OFF, ws, ST, vcu, G);
    GRID_BAR();

    REP_BEGIN(3)
    {
        pg8::Gemm g{(const bf16*)(ws + A_QR), (const bf16*)(ws + W_UR), 2 * M, 2 * D, 1024}; DualOrder S; S.init(M, D, G, bx);
        EpiUp E{ws};
        pg8::gemm_phase<EpiUp, DualOrder, PG8_ALIGN, PG8_SP2>(L + RING_OFF, g, S, E);
    }
    GRID_BAR();
    REP_END
    REP_BEGIN(4)
    {
        pg8::Gemm g{(const bf16*)(ws + A_MERGED), (const bf16*)(ws + W_O), M, D, D}; pg8::StaticOrder S; S.init(M, D, G, bx);
        EpiResid E{x, out, (bf16*)(ws + A_H1B), (float*)(ws + WS_SSQ1), (LAS float*)(L + XTRA_OFF + 2048)};
        pg8::gemm_phase<EpiResid, pg8::StaticOrder, PG8_ALIGN, PG8_SP2>(L + RING_OFF, g, S, E);
    }
    GRID_BAR();
    REP_END
    REP_BEGIN(5)
    {
        pg8::Gemm g{(const bf16*)(ws + A_H1B), (const bf16*)(ws + W_XQ), M, 512, D}; pg8::StaticOrder S; S.init(M, 512, G, bx);
        EpiRstd E{(bf16*)(ws + A_XQ), 512, (const float*)(ws + WS_SSQ1), 0.08838834764831845f * 1.4426950408889634f};
        pg8::gemm_phase<EpiRstd, pg8::StaticOrder, PG8_ALIGN, PG8_SP2>(L + RING_OFF, g, S, E);
    }
    GRID_BAR();
    REP_END
    REP_BEGIN(6)
    xattn_phase(L + RING_OFF, ws, vcu, G);
    GRID_BAR();
    REP_END
    {
        pg8::Gemm g{(const bf16*)(ws + A_XA), (const bf16*)(ws + W_XO), M, D, 512}; pg8::StaticOrder S; S.init(M, D, G, bx);
        EpiResid E{out, out, (bf16*)(ws + A_H2B), (float*)(ws + WS_SSQ2), (LAS float*)(L + XTRA_OFF + 2048)};
        pg8::gemm_phase<EpiResid, pg8::StaticOrder, PG8_ALIGN, PG8_SP2>(L + RING_OFF, g, S, E);
    }
    GRID_BAR();
    REP_BEGIN(7)
    {
        pg8::Gemm g{(const bf16*)(ws + A_H2B), (const bf16*)(ws + W_GU), M, 2 * DFF, D}; pg8::StaticOrder S; S.init(M, 2 * DFF, G, bx);
#if (REP_MASK >> 8) & 1
        { EpiHalfPlain E0{(bf16*)(ws + A_ACTF)}; pg8::gemm_phase<EpiHalfPlain, pg8::StaticOrder, PG8_ALIGN, PG8_SP2>(L + RING_OFF, g, S, E0); GRID_BAR(); }
#endif
        EpiGateUp E{(bf16*)(ws + A_ACTF), (const float*)(ws + WS_SSQ2)};
        pg8::gemm_phase<EpiGateUp, pg8::StaticOrder, PG8_ALIGN, PG8_SP2>(L + RING_OFF, g, S, E);
    }
    GRID_BAR();
    REP_END
    {
        pg8::Gemm g{(const bf16*)(ws + A_ACTF), (const bf16*)(ws + W_DN), M, D, DFF}; pg8::StaticOrder S; S.init(M, D, G, bx);
        EpiResid E{out, out, nullptr, (float*)(ws + WS_SSQ3), (LAS float*)(L + XTRA_OFF + 2048)};
        pg8::gemm_phase<EpiResid, pg8::StaticOrder, PG8_ALIGN, PG8_SP2>(L + RING_OFF, g, S, E);
    }
    GRID_BAR();
    {
        const float* ssq = (const float*)(ws + WS_SSQ3);
        int t9 = threadIdx.x; asm volatile("" : "+v"(t9)); const int lane = t9 & 63;
        for (int m = gw; m < M; m += NGW) {
            const float rs = rstd_of(*(const f4*)(ssq + (size_t)m * 8), *(const f4*)(ssq + (size_t)m * 8 + 4));
            GAS f4* xr = (GAS f4*)(out + (size_t)m * D) + lane; const GAS f4* gr = (const GAS f4*)g_final + lane;
#pragma unroll
            for (int j = 0; j < 8; ++j) { const f4 v = xr[64 * j], gg = gr[64 * j]; xr[64 * j] = v * rs * gg; }
        }
    }
}

extern "C" void kernel_launch(void* const* d_in, const int* in_sizes, int n_in, void* d_out, int out_size, void* d_ws, size_t ws_size, hipStream_t stream) {
    static int grid = 0;
    if (grid == 0) {
        if (n_in != 19 || in_sizes[0] != M * D || out_size != M * D || ws_size < WS_END) { fprintf(stderr, "kernel_launch: unexpected shapes (n_in %d, in0 %d, out %d, ws %zu); nothing launched\n", n_in, n_in > 0 ? in_sizes[0] : -1, out_size, ws_size); grid = -1; return; }
        int dev = 0, cus = 0, per_cu = 0;
        if (hipGetDevice(&dev) != hipSuccess || hipDeviceGetAttribute(&cus, hipDeviceAttributeMultiprocessorCount, dev) != hipSuccess) { grid = -1; return; }
        if (hipFuncSetAttribute((const void*)hybrid_fwd, hipFuncAttributeMaxDynamicSharedMemorySize, LDS_BYTES) != hipSuccess) { fprintf(stderr, "kernel_launch: hipFuncSetAttribute failed\n"); grid = -1; return; }
        if (hipOccupancyMaxActiveBlocksPerMultiprocessor(&per_cu, (const void*)hybrid_fwd, NWAVES * 64, LDS_BYTES) != hipSuccess || per_cu < 1)
            fprintf(stderr, "kernel_launch: note: occupancy query reports %d workgroups per CU\n", per_cu);
        (void)hipGetLastError();
        grid = cus;
    }
    if (grid < 0) return;
    if (hipMemsetAsync((char*)d_ws + WS_CTL, 0, CTL_ZERO_BYTES, stream) != hipSuccess) { fprintf(stderr, "kernel_launch: hipMemsetAsync failed\n"); return; }
    Args a{};
    a.in[0] = (const float*)d_in[0]; a.in[1] = (const float*)d_in[1]; a.pos = (const int*)d_in[2];
    for (int i = 3; i < 19; ++i) a.in[i - 1] = (const float*)d_in[i];
    a.in[18] = nullptr;
    a.out = (float*)d_out; a.ws = (unsigned char*)d_ws;
    hipLaunchKernelGGL(hybrid_fwd, dim3(grid), dim3(NWAVES * 64), LDS_BYTES, stream, a);
    const hipError_t le = hipPeekAtLastError();
    if (le != hipSuccess) fprintf(stderr, "kernel_launch: launch failed: %s\n", hipGetErrorName(le));
}
```
